# Optimizing an MI355X kernel written in HIP

```python
import math
import jax, jax.numpy as jnp
from jax import lax
import numpy as np

D_MODEL = 1024
BATCH = 8
SEQ = 2048
DEPTH = 4

N_MIXERS = 3
MEM_LEN = 256
DA_HEADS = 8
DA_HEAD_DIM = 64
DA_QBLOCK = 128
ROPE_THETA = 10000.0
POOL_WINDOWS = (2, 4, 8, 16)
POOL_GROUPS = len(POOL_WINDOWS)
POOL_GROUP_DIM = D_MODEL // POOL_GROUPS
RET_HEADS = 4
RET_QK_DIM = D_MODEL // RET_HEADS
RET_V_DIM = 2 * RET_QK_DIM
RET_CHUNK = 128
XA_HEADS = 4
XA_HEAD_DIM = D_MODEL // XA_HEADS
D_FF = 2816
DEEPNORM_ALPHA = (2 * DEPTH) ** 0.25
DEEPNORM_BETA = (8 * DEPTH) ** -0.25
LN_EPS = 1e-5

N_DA = len(range(0, DEPTH, N_MIXERS))
N_POOL = len(range(1, DEPTH, N_MIXERS))
N_RET = len(range(2, DEPTH, N_MIXERS))

kernel_name = "hybrid_diffattn_pool_retention_deepnorm"


def layer_norm(x, g, b):
    xf = x.astype(jnp.float32)
    mu = jnp.mean(xf, axis=-1, keepdims=True)
    var = jnp.mean(jnp.square(xf - mu), axis=-1, keepdims=True)
    y = (xf - mu) * lax.rsqrt(var + LN_EPS) * g.astype(jnp.float32) + b.astype(jnp.float32)
    return y.astype(x.dtype)


def rope(x, cos, sin):
    half = x.shape[-1] // 2
    xf = x.astype(jnp.float32)
    x1, x2 = xf[..., :half], xf[..., half:]
    return jnp.concatenate([x1 * cos - x2 * sin, x2 * cos + x1 * sin], axis=-1).astype(x.dtype)


def swiglu_ffn(x, w_in, w_out):
    h = x @ w_in
    g, u = jnp.split(h, 2, axis=-1)
    return (jax.nn.silu(g) * u) @ w_out


def diff_attention(x, w_qkv, w_o, lam_q, lam_k, subln_g, cos, sin, lam_init):
    B, S, _ = x.shape
    H, dk = DA_HEADS, DA_HEAD_DIM
    q, k, v = jnp.split(x @ w_qkv, 3, axis=-1)
    q = q.reshape(B, S, H, 2, dk)
    k = k.reshape(B, S, H, 2, dk)
    v = v.reshape(B, S, H, 2 * dk)
    c5, s5 = cos[:, :, None, None, :], sin[:, :, None, None, :]
    q = rope(q, c5, s5)
    k = rope(k, c5, s5)
    lq = lam_q.astype(jnp.float32)
    lk = lam_k.astype(jnp.float32)
    lam = jnp.exp(jnp.sum(lq[0] * lk[0])) - jnp.exp(jnp.sum(lq[1] * lk[1])) + lam_init
    scale = dk ** -0.5
    nb = S // DA_QBLOCK
    qb = q.reshape(B, nb, DA_QBLOCK, H, 2, dk).transpose(1, 0, 2, 3, 4, 5)
    kpos = jnp.arange(S)

    def block(args):
        qblk, i = args
        s = jnp.einsum('bqhcd,bkhcd->bhcqk', qblk, k).astype(jnp.float32) * scale
        qpos = i * DA_QBLOCK + jnp.arange(DA_QBLOCK)
        mask = kpos[None, :] <= qpos[:, None]
        s = jnp.where(mask, s, jnp.finfo(jnp.float32).min)
        p = jax.nn.softmax(s, axis=-1)
        a = p[:, :, 0] - lam * p[:, :, 1]
        return jnp.einsum('bhqk,bkhe->bqhe', a.astype(v.dtype), v)

    o = lax.map(block, (qb, jnp.arange(nb)))
    o = o.transpose(1, 0, 2, 3, 4).reshape(B, S, H, 2 * dk).astype(jnp.float32)
    o = o * lax.rsqrt(jnp.mean(jnp.square(o), axis=-1, keepdims=True) + LN_EPS)
    o = o * subln_g.astype(jnp.float32) * (1.0 - lam_init)
    return o.reshape(B, S, H * 2 * dk).astype(x.dtype) @ w_o


def pool_mixer(x, w_grp, b_grp, scale):
    B, S, D = x.shape
    xg = x.reshape(B, S, POOL_GROUPS, POOL_GROUP_DIM).astype(jnp.float32)
    cs = jnp.cumsum(xg, axis=1)
    t = jnp.arange(S)
    pooled = []
    for g, w in enumerate(POOL_WINDOWS):
        c = cs[:, :, g]
        prev = jnp.pad(c, ((0, 0), (w, 0), (0, 0)))[:, :S]
        cnt = jnp.minimum(t + 1, w).astype(jnp.float32)[None, :, None]
        pooled.append((c - prev) / cnt)
    pooled = jnp.stack(pooled, axis=2) - xg
    y = jnp.einsum('bsgc,gcd->bsgd', pooled.astype(x.dtype), w_grp) + b_grp
    return y.reshape(B, S, D) * scale


def retention(x, w_qkvg, w_o, cos, sin):
    B, S, _ = x.shape
    H, dk, dv, C = RET_HEADS, RET_QK_DIM, RET_V_DIM, RET_CHUNK
    proj = x @ w_qkvg
    q, k, v, g = jnp.split(proj, [H * dk, 2 * H * dk, 2 * H * dk + H * dv], axis=-1)
    c4, s4 = cos[:, :, None, :], sin[:, :, None, :]
    q = rope(q.reshape(B, S, H, dk), c4, s4).astype(jnp.float32)
    k = rope(k.reshape(B, S, H, dk), c4, s4).astype(jnp.float32) * (dk ** -0.5)
    v = v.reshape(B, S, H, dv).astype(jnp.float32)
    log_gamma = jnp.log(1.0 - jnp.exp2(-5.0 - jnp.arange(H, dtype=jnp.float32)))
    idx = jnp.arange(C, dtype=jnp.float32)
    rel = idx[:, None] - idx[None, :]
    d_intra = jnp.where(rel[None] >= 0,
                        jnp.exp(jnp.maximum(rel, 0.0)[None] * log_gamma[:, None, None]), 0.0)
    q_decay = jnp.exp((idx[:, None] + 1.0) * log_gamma[None, :])
    k_decay = jnp.exp((C - 1.0 - idx[:, None]) * log_gamma[None, :])
    chunk_decay = jnp.exp(C * log_gamma)
    nc = S // C

    def to_chunks(a):
        return a.reshape(B, nc, C, H, a.shape[-1]).transpose(1, 0, 2, 3, 4)

    def step(R, inp):
        qc, kc, vc = inp
        att = jnp.einsum('bihd,bjhd->bhij', qc, kc) * d_intra[None]
        inner = jnp.einsum('bhij,bjhe->bihe', att, vc)
        cross = jnp.einsum('bihd,bhde->bihe', qc, R) * q_decay[None, :, :, None]
        R = R * chunk_decay[None, :, None, None] + jnp.einsum(
            'bjhd,bjhe->bhde', kc * k_decay[None, :, :, None], vc)
        return R, inner + cross

    R0 = jnp.zeros((B, H, dk, dv), jnp.float32)
    _, o = lax.scan(step, R0, (to_chunks(q), to_chunks(k), to_chunks(v)))
    o = o.transpose(1, 0, 2, 3, 4).reshape(B, S, H, dv)
    mu = jnp.mean(o, axis=-1, keepdims=True)
    var = jnp.mean(jnp.square(o - mu), axis=-1, keepdims=True)
    o = ((o - mu) * lax.rsqrt(var + LN_EPS)).reshape(B, S, H * dv).astype(x.dtype)
    return (jax.nn.silu(g) * o) @ w_o


def memory_cross_attention(x, mem, wq, wkv, wo):
    B, S, _ = x.shape
    M = mem.shape[1]
    q = (x @ wq).reshape(B, S, XA_HEADS, XA_HEAD_DIM)
    k, v = jnp.split(mem @ wkv, 2, axis=-1)
    k = k.reshape(B, M, XA_HEADS, XA_HEAD_DIM)
    v = v.reshape(B, M, XA_HEADS, XA_HEAD_DIM)
    s = jnp.einsum('bshd,bmhd->bhsm', q, k).astype(jnp.float32) * (XA_HEAD_DIM ** -0.5)
    p = jax.nn.softmax(s, axis=-1).astype(v.dtype)
    o = jnp.einsum('bhsm,bmhd->bshd', p, v).reshape(B, S, D_MODEL)
    return o @ wo


def setup_inputs(seed: int = 0) -> dict:
    key = jax.random.key(seed)
    ks = jax.random.split(key, 24)
    f32 = jnp.float32
    D, F = D_MODEL, D_FF
    nrm = lambda k, shape, std: jax.random.normal(k, shape, f32) * std
    x = nrm(ks[0], (BATCH, SEQ, D), 1.0)
    mem = nrm(ks[1], (BATCH, MEM_LEN, D), 1.0)
    offset = jax.random.randint(ks[2], (BATCH, 1), 0, 4096, dtype=jnp.int32)
    positions = (jnp.arange(SEQ, dtype=jnp.int32)[None, :] + offset).astype(jnp.int32)
    ffn_w_in = nrm(ks[3], (DEPTH, 2, D, 2 * F), D ** -0.5)
    ffn_w_out = nrm(ks[4], (DEPTH, 2, F, D), F ** -0.5 * DEEPNORM_BETA)
    ln_g = 1.0 + nrm(ks[5], (DEPTH, 4, D), 0.02)
    ln_b = nrm(ks[6], (DEPTH, 4, D), 0.02)
    da_w_qkv = nrm(ks[7], (N_DA, D, 3 * DA_HEADS * 2 * DA_HEAD_DIM), D ** -0.5)
    da_w_o = nrm(ks[8], (N_DA, DA_HEADS * 2 * DA_HEAD_DIM, D),
                 (DA_HEADS * 2 * DA_HEAD_DIM) ** -0.5 * DEEPNORM_BETA)
    da_lam_q = nrm(ks[9], (N_DA, 2, DA_HEAD_DIM), 0.1)
    da_lam_k = nrm(ks[10], (N_DA, 2, DA_HEAD_DIM), 0.1)
    da_subln_g = 1.0 + nrm(ks[11], (N_DA, 2 * DA_HEAD_DIM), 0.02)
    pool_w = nrm(ks[12], (N_POOL, POOL_GROUPS, POOL_GROUP_DIM, POOL_GROUP_DIM),
                 POOL_GROUP_DIM ** -0.5 * DEEPNORM_BETA)
    pool_b = nrm(ks[13], (N_POOL, POOL_GROUPS, POOL_GROUP_DIM), 0.02)
    pool_scale = 1.0 + nrm(ks[14], (N_POOL, D), 0.02)
    ret_w_qkvg = nrm(ks[15], (N_RET, D, 2 * RET_HEADS * RET_QK_DIM + 2 * RET_HEADS * RET_V_DIM),
                     D ** -0.5)
    ret_w_o = nrm(ks[16], (N_RET, RET_HEADS * RET_V_DIM, D),
                  (RET_HEADS * RET_V_DIM) ** -0.5 * DEEPNORM_BETA)
    xa_wq = nrm(ks[17], (DEPTH, D, D), D ** -0.5)
    xa_wkv = nrm(ks[18], (DEPTH, D, 2 * D), D ** -0.5)
    xa_wo = nrm(ks[19], (DEPTH, D, D), D ** -0.5 * DEEPNORM_BETA)
    return {"x": x, "mem": mem, "positions": positions,
            "ffn_w_in": ffn_w_in, "ffn_w_out": ffn_w_out, "ln_g": ln_g, "ln_b": ln_b,
            "da_w_qkv": da_w_qkv, "da_w_o": da_w_o, "da_lam_q": da_lam_q,
            "da_lam_k": da_lam_k, "da_subln_g": da_subln_g,
            "pool_w": pool_w, "pool_b": pool_b, "pool_scale": pool_scale,
            "ret_w_qkvg": ret_w_qkvg, "ret_w_o": ret_w_o,
            "xa_wq": xa_wq, "xa_wkv": xa_wkv, "xa_wo": xa_wo}


def reference(x, mem, positions, ffn_w_in, ffn_w_out, ln_g, ln_b,
              da_w_qkv, da_w_o, da_lam_q, da_lam_k, da_subln_g,
              pool_w, pool_b, pool_scale, ret_w_qkvg, ret_w_o,
              xa_wq, xa_wkv, xa_wo):
    pos = positions.astype(jnp.float32)[..., None]
    da_inv = 1.0 / (ROPE_THETA ** (jnp.arange(0, DA_HEAD_DIM, 2, dtype=jnp.float32) / DA_HEAD_DIM))
    da_ang = pos * da_inv[None, None, :]
    da_cos, da_sin = jnp.cos(da_ang), jnp.sin(da_ang)
    ret_inv = 1.0 / (ROPE_THETA ** jnp.linspace(0.0, 1.0, RET_QK_DIM // 2, dtype=jnp.float32))
    ret_ang = pos * ret_inv[None, None, :]
    ret_cos, ret_sin = jnp.cos(ret_ang), jnp.sin(ret_ang)
    a = DEEPNORM_ALPHA
    for i in range(DEPTH):
        m, j = i % N_MIXERS, i // N_MIXERS
        x = layer_norm(a * x + 0.5 * swiglu_ffn(x, ffn_w_in[i, 0], ffn_w_out[i, 0]),
                       ln_g[i, 0], ln_b[i, 0])
        if m == 0:
            lam_init = 0.8 - 0.6 * math.exp(-0.3 * i)
            h = diff_attention(x, da_w_qkv[j], da_w_o[j], da_lam_q[j], da_lam_k[j],
                               da_subln_g[j], da_cos, da_sin, lam_init)
        elif m == 1:
            h = pool_mixer(x, pool_w[j], pool_b[j], pool_scale[j])
        else:
            h = retention(x, ret_w_qkvg[j], ret_w_o[j], ret_cos, ret_sin)
        x = layer_norm(a * x + h, ln_g[i, 1], ln_b[i, 1])
        x = layer_norm(a * x + memory_cross_attention(x, mem, xa_wq[i], xa_wkv[i], xa_wo[i]),
                       ln_g[i, 2], ln_b[i, 2])
        x = layer_norm(a * x + 0.5 * swiglu_ffn(x, ffn_w_in[i, 1], ffn_w_out[i, 1]),
                       ln_g[i, 3], ln_b[i, 3])
    return x
```

```cpp
#include <hip/hip_runtime.h>
#include <hip/hip_cooperative_groups.h>
#include <cstdio>
#include <cstdint>
#include <cmath>
#include <cstring>
namespace cg = cooperative_groups;

#define DI __device__ __forceinline__
typedef unsigned short bf16_t;
typedef short bf16x8 __attribute__((ext_vector_type(8)));
typedef short s16x4 __attribute__((ext_vector_type(4)));
typedef float f32x16 __attribute__((ext_vector_type(16)));
typedef float f32x4 __attribute__((ext_vector_type(4)));
typedef float f32x2 __attribute__((ext_vector_type(2)));
typedef unsigned u32x4 __attribute__((ext_vector_type(4)));
typedef unsigned u32x2 __attribute__((ext_vector_type(2)));
typedef __bf16 bf2_t __attribute__((ext_vector_type(2)));

#ifndef PROBE_DUP
#define PROBE_DUP 0
#endif
constexpr int NT = 512;
constexpr int T_ = 16384, D_ = 1024, S_ = 2048, F_ = 2816;
constexpr int LDS_BYTES = 139264;
constexpr float LN_EPS = 1e-5f;
constexpr float ALPHA = 1.681792830507429f;
constexpr float LOG2E = 1.4426950408889634f;

DI unsigned pack2(float lo, float hi) { f32x2 v = {lo, hi}; bf2_t r = __builtin_convertvector(v, bf2_t); return __builtin_bit_cast(unsigned, r); }
DI bf16_t f2bf(float x) { return (bf16_t)(pack2(x, 0.f) & 0xffffu); }
DI float bf2f(bf16_t v) { return __uint_as_float(((unsigned)v) << 16); }
DI int crow(int i, int hh) { return (i & 3) + 8 * (i >> 2) + 4 * hh; }
DI f32x16 mfma(bf16x8 a, bf16x8 b, f32x16 c) { return __builtin_amdgcn_mfma_f32_32x32x16_bf16(a, b, c, 0, 0, 0); }
DI f32x16 zero16() { f32x16 z; for (int i = 0; i < 16; ++i) z[i] = 0.f; return z; }
DI float ex2(float x) { return __builtin_amdgcn_exp2f(x); }
DI int launder(int x) { asm volatile("" : "+v"(x)); return x; }


typedef unsigned long long u64_t;
DI unsigned ag_ld32(unsigned* p) { return __hip_atomic_load(p, __ATOMIC_RELAXED, __HIP_MEMORY_SCOPE_AGENT); }
DI unsigned ag_add32(unsigned* p, unsigned v) { return __hip_atomic_fetch_add(p, v, __ATOMIC_RELAXED, __HIP_MEMORY_SCOPE_AGENT); }
DI u64_t ag_ld64(u64_t* p) { return __hip_atomic_load(p, __ATOMIC_RELAXED, __HIP_MEMORY_SCOPE_AGENT); }
DI void ag_st64(u64_t* p, u64_t v) { __hip_atomic_store(p, v, __ATOMIC_RELAXED, __HIP_MEMORY_SCOPE_AGENT); }


template <int CTRL> DI float dpp_f(float v) { return __int_as_float(__builtin_amdgcn_update_dpp(0, __float_as_int(v), CTRL, 0xF, 0xF, true)); }
DI float row16_sum(float v) {
  v += dpp_f<0xB1>(v);
  v += dpp_f<0x4E>(v);
  v += dpp_f<0x141>(v);
  v += dpp_f<0x140>(v);
  return v;
}


DI float xhalf_max(float v) { auto r = __builtin_amdgcn_permlane32_swap(__float_as_uint(v), __float_as_uint(v), false, false); return fmaxf(__uint_as_float(r[0]), __uint_as_float(r[1])); }
DI float xhalf_sum(float v) { auto r = __builtin_amdgcn_permlane32_swap(__float_as_uint(v), __float_as_uint(v), false, false); return __uint_as_float(r[0]) + __uint_as_float(r[1]); }

struct TJob { const float* src; bf16_t* dst; int K, N, lds_, ldd, perm, pad; };
constexpr int NJOBS = 35;

struct Params {
  const float *x, *mem; const int* pos;
  const float *ln_g, *ln_b, *lam_q, *lam_k, *subln_g, *pool_b, *pool_scale;
  float* out; unsigned* bar; unsigned* xcnt; unsigned* xrank; u64_t* xstat;
  float* X; bf16_t* Xb; bf16_t* memb;
  float *cosD, *sinD, *cosR, *sinR;
  bf16_t *Kx, *Vxt;
  bf16_t *H, *Q, *Kb, *Vt, *Oa, *Vrt, *G, *Or;
  const bf16_t *win[8], *wout[8], *wqkv[2], *wdo[2], *wpool, *wret, *wreto, *wxq[4], *wxkv[4], *wxo[4];
  float lam_init[2];
  int njobs; int pad;
  int tile_start[NJOBS + 1];
  TJob jobs[NJOBS];
};

template <int BK> DI int swz(int row) { constexpr int CPR = BK / 8; return (row / (16 / CPR)) % CPR; }

template <int ROWS, int BK>
DI void stage_tile(const bf16_t* g, int ld, char* l, int tid) {
  constexpr int CPR = BK / 8, TOT = ROWS * CPR, N = (TOT + NT - 1) / NT;
  const int row0 = tid / CPR, pc = tid % CPR; const int c = pc ^ swz<BK>(row0);
  const unsigned voff = (unsigned)(row0 * ld + c * 8) * 2u;
#pragma unroll
  for (int i = 0; i < N; ++i) {
    if (TOT % NT == 0 || tid + i * NT < TOT) {
      const char* gb = (const char*)g + (size_t)i * (NT / CPR) * ld * 2;
      __builtin_amdgcn_global_load_lds((const unsigned*)(gb + voff), (__attribute__((address_space(3))) unsigned*)(l + i * NT * 16 + __builtin_amdgcn_readfirstlane(tid >> 6) * 1024), 16, 0, 0);
    }
  }
}
DI void wait_vm0() { asm volatile("s_waitcnt vmcnt(0)" ::: "memory"); }

template <int ROWS, int BK>
DI void stage_piece(const bf16_t* g, int ld, char* l, int tid, int i, int wv) {
  constexpr int CPR = BK / 8, TOT = ROWS * CPR;
  const int row0 = tid / CPR, pc = tid % CPR; const int c = pc ^ swz<BK>(row0);
  const unsigned voff = (unsigned)(row0 * ld + c * 8) * 2u;
  if (TOT % NT == 0 || tid + i * NT < TOT) {
    const char* gb = (const char*)g + (size_t)i * (NT / CPR) * ld * 2;
    __builtin_amdgcn_global_load_lds((const unsigned*)(gb + voff), (__attribute__((address_space(3))) unsigned*)(l + i * NT * 16 + wv * 1024), 16, 0, 0);
  }
}

template <int WM, int BK, class Epi, int NTW = 4>
DI void gemm_tile(const bf16_t* __restrict__ A, int lda, const bf16_t* __restrict__ Bt, int ldb, int K, int row0, int col0, char* lds, Epi& epi,
                  bool pre = false, bool has_next = false, int row0n = 0, int col0n = 0) {
  constexpr int WN = 8 / WM, BM = 64 * WM, BN = 32 * NTW * WN, ABYTES = BM * BK * 2, STG = (BM + BN) * BK * 2;
  constexpr int NKK = BK / 16;
  constexpr int NPA = (BM * (BK / 8) + NT - 1) / NT, NPB = (BN * (BK / 8) + NT - 1) / NT, NP = NPA + NPB, PPK = (NP + NKK - 1) / NKK;
  static_assert(2 * STG <= LDS_BYTES, "lds");
  const int tid = launder(threadIdx.x), lane = tid & 63, w = tid >> 6, wm = w % WM, wn = w / WM;
  const int l31 = lane & 31, hh = lane >> 5;
  f32x16 acc[2][NTW];
#pragma unroll
  for (int a = 0; a < 2; ++a)
#pragma unroll
    for (int b = 0; b < NTW; ++b) acc[a][b] = zero16();
  const bf16_t* Ag = A + (size_t)row0 * lda; const bf16_t* Bg = Bt + (size_t)col0 * ldb;
  const int wv = __builtin_amdgcn_readfirstlane(tid >> 6);
  __syncthreads();
  if (!pre) { stage_tile<BM, BK>(Ag, lda, lds, tid); stage_tile<BN, BK>(Bg, ldb, lds + ABYTES, tid); }
  wait_vm0();
  __syncthreads();
  const int nk = K / BK;
  for (int kt = 0; kt < nk; ++kt) {
    char* cur = lds + (kt & 1) * STG; char* nxt = lds + ((kt + 1) & 1) * STG;
    const bool more = kt + 1 < nk;
    const bf16_t* An = Ag + (kt + 1) * BK; const bf16_t* Bn = Bg + (kt + 1) * BK;
    if (!more) epi.pre(row0 + wm * 64, col0 + wn * (32 * NTW), lane, w, lds);
    bf16x8 fa[2][2], fb[2][NTW];
#pragma unroll
    for (int mt = 0; mt < 2; ++mt) { int row = wm * 64 + mt * 32 + l31; fa[0][mt] = *(const bf16x8*)(cur + row * (BK * 2) + ((hh ^ swz<BK>(row)) << 4)); }
#pragma unroll
    for (int nt = 0; nt < NTW; ++nt) { int row = wn * (32 * NTW) + nt * 32 + l31; fb[0][nt] = *(const bf16x8*)(cur + ABYTES + row * (BK * 2) + ((hh ^ swz<BK>(row)) << 4)); }
#pragma unroll
    for (int kk = 0; kk < NKK; ++kk) {
      if (kk + 1 < NKK) {
        const int ch = (kk + 1) * 2 + hh;
#pragma unroll
        for (int mt = 0; mt < 2; ++mt) { int row = wm * 64 + mt * 32 + l31; fa[(kk + 1) & 1][mt] = *(const bf16x8*)(cur + row * (BK * 2) + ((ch ^ swz<BK>(row)) << 4)); }
#pragma unroll
        for (int nt = 0; nt < NTW; ++nt) { int row = wn * (32 * NTW) + nt * 32 + l31; fb[(kk + 1) & 1][nt] = *(const bf16x8*)(cur + ABYTES + row * (BK * 2) + ((ch ^ swz<BK>(row)) << 4)); }
      }
      if (more) {
#pragma unroll
        for (int q = 0; q < PPK; ++q) {
          const int pi = kk * PPK + q;
          if (pi < NPA) stage_piece<BM, BK>(An, lda, nxt, tid, pi, wv);
          else if (pi < NP) stage_piece<BN, BK>(Bn, ldb, nxt + ABYTES, tid, pi - NPA, wv);
        }
      }
      __builtin_amdgcn_s_setprio(1);
#pragma unroll
      for (int mt = 0; mt < 2; ++mt)
#pragma unroll
        for (int nt = 0; nt < NTW; ++nt) acc[mt][nt] = mfma(fa[kk & 1][mt], fb[kk & 1][nt], acc[mt][nt]);
      __builtin_amdgcn_s_setprio(0);
      __builtin_amdgcn_sched_barrier(0);
    }
    wait_vm0();
    __syncthreads();
  }
  if (has_next) { const int tid3 = launder(threadIdx.x); stage_tile<BM, BK>(A + (size_t)row0n * lda, lda, lds, tid3); stage_tile<BN, BK>(Bt + (size_t)col0n * ldb, ldb, lds + ABYTES, tid3); }
  { const int tid2 = launder(threadIdx.x); epi(acc, row0 + (((tid2 >> 6) % WM) * 64), col0 + (((tid2 >> 6) / WM) * (32 * NTW)), tid2 & 63, tid2 >> 6, lds); }
}

template <class Epi>
DI void gemm_tile_p4(const bf16_t* __restrict__ A, int lda, const bf16_t* __restrict__ Bt, int ldb, int K, int row0, int col0, char* lds, Epi& epi) {
  constexpr int BK = 32, BM = 256, BN = 256, ABYTES = BM * BK * 2, STG = (BM + BN) * BK * 2, NS = 4;
  static_assert(NS * STG <= LDS_BYTES, "lds");
  const int tid = launder(threadIdx.x), lane = tid & 63, w = tid >> 6, wm = w & 3, wn = w >> 2;
  const int l31 = lane & 31, hh = lane >> 5;
  f32x16 acc[2][4];
#pragma unroll
  for (int a = 0; a < 2; ++a)
#pragma unroll
    for (int b = 0; b < 4; ++b) acc[a][b] = zero16();
  const bf16_t* Ag = A + (size_t)row0 * lda; const bf16_t* Bg = Bt + (size_t)col0 * ldb;
  const int nk = K / BK;
  __syncthreads();
#pragma unroll
  for (int s = 0; s < NS - 1; ++s) { stage_tile<BM, BK>(Ag + s * BK, lda, lds + s * STG, tid); stage_tile<BN, BK>(Bg + s * BK, ldb, lds + s * STG + ABYTES, tid); }
  int aoff[2][2], boff[4][2];
#pragma unroll
  for (int kk = 0; kk < 2; ++kk) {
    const int ch = kk * 2 + hh;
#pragma unroll
    for (int mt = 0; mt < 2; ++mt) { int row = wm * 64 + mt * 32 + l31; aoff[mt][kk] = row * (BK * 2) + ((ch ^ swz<BK>(row)) << 4); }
#pragma unroll
    for (int nt = 0; nt < 4; ++nt) { int row = wn * 128 + nt * 32 + l31; boff[nt][kk] = ABYTES + row * (BK * 2) + ((ch ^ swz<BK>(row)) << 4); }
  }
  for (int kt = 0; kt < nk; ++kt) {
    if (kt + 2 < nk) asm volatile("s_waitcnt vmcnt(8)" ::: "memory");
    else if (kt + 1 < nk) asm volatile("s_waitcnt vmcnt(4)" ::: "memory");
    else asm volatile("s_waitcnt vmcnt(0)" ::: "memory");
    __builtin_amdgcn_s_barrier();
    asm volatile("" ::: "memory");
    if (kt + NS - 1 < nk) { char* nxt = lds + ((kt + NS - 1) & (NS - 1)) * STG; stage_tile<BM, BK>(Ag + (kt + NS - 1) * BK, lda, nxt, tid); stage_tile<BN, BK>(Bg + (kt + NS - 1) * BK, ldb, nxt + ABYTES, tid); }
    const char* cur = lds + (kt & (NS - 1)) * STG;
#pragma unroll
    for (int kk = 0; kk < 2; ++kk) {
      bf16x8 a[2], b[4];
#pragma unroll
      for (int mt = 0; mt < 2; ++mt) a[mt] = *(const bf16x8*)(cur + aoff[mt][kk]);
#pragma unroll
      for (int nt = 0; nt < 4; ++nt) b[nt] = *(const bf16x8*)(cur + boff[nt][kk]);
#pragma unroll
      for (int mt = 0; mt < 2; ++mt)
#pragma unroll
        for (int nt = 0; nt < 4; ++nt) acc[mt][nt] = mfma(a[mt], b[nt], acc[mt][nt]);
    }
  }
  __syncthreads();
  { const int tid2 = launder(threadIdx.x); epi(acc, row0 + (((tid2 >> 6) & 3) * 64), col0 + (((tid2 >> 6) >> 2) * 128), tid2 & 63, tid2 >> 6, lds); }
}

struct EpiSwiglu {
  DI void pre(int, int, int, int, char*) {}
  bf16_t* H;
  template <int NTW>
  DI void operator()(f32x16 (&acc)[2][NTW], int grow0, int gcol0, int lane, int w, char* lds) {
    const int l31 = lane & 31, hh = lane >> 5;
#pragma unroll
    for (int mt = 0; mt < 2; ++mt)
#pragma unroll
      for (int pr = 0; pr < NTW / 2; ++pr) {
        const int col = (gcol0 / 64 + pr) * 32 + l31;
#pragma unroll
        for (int i = 0; i < 16; ++i) {
          float g = acc[mt][2 * pr][i], u = acc[mt][2 * pr + 1][i];
          float v = g * __builtin_amdgcn_rcpf(1.f + __expf(-g)) * u;
          int row = grow0 + mt * 32 + crow(i, hh);
          H[(size_t)row * F_ + col] = f2bf(v);
        }
      }
  }
};

struct EpiLN {
  DI void pre(int, int, int, int, char*) {}
  const float* Xin; float* Xout; bf16_t* Xb; const float* bias; const float* cscale; const float* g; const float* b; float hs;
  DI void operator()(f32x16 (&acc)[2][4], int grow0, int gcol0, int lane, int w, char* lds) {
    float* red = (float*)lds; float* stat = red + 8 * 64 * 2;
    const int l31 = lane & 31, hh = lane >> 5, tid = w * 64 + lane;
    float bia[4], csc[4];
#pragma unroll
    for (int nt = 0; nt < 4; ++nt) { int c = gcol0 + nt * 32 + l31; bia[nt] = bias ? bias[c] : 0.f; csc[nt] = cscale ? cscale[c] : 1.f; }
    const unsigned base1 = (unsigned)((grow0 + 4 * hh) * D_ + gcol0 + l31);
#pragma unroll
    for (int mt = 0; mt < 2; ++mt) {
#pragma unroll
      for (int i = 0; i < 16; ++i) {
        const unsigned off = base1 + (unsigned)((mt * 32 + (i & 3) + 8 * (i >> 2)) * D_);
        float s1 = 0.f, s2 = 0.f;
#pragma unroll
        for (int nt = 0; nt < 4; ++nt) {
          float v = (acc[mt][nt][i] + bia[nt]) * csc[nt];
          float z = ALPHA * Xin[off + nt * 32] + hs * v;
          acc[mt][nt][i] = z; s1 += z; s2 += z * z;
        }
#pragma unroll
        for (int o = 16; o > 0; o >>= 1) { s1 += __shfl_xor(s1, o); s2 += __shfl_xor(s2, o); }
        if (l31 == 0) { int lr = mt * 32 + crow(i, hh); f32x2 sv = {s1, s2}; *(f32x2*)(red + (w * 64 + lr) * 2) = sv; }
        asm volatile("" ::: "memory");
      }
    }
    __syncthreads();
    if (tid < 64) {
      float s1 = 0.f, s2 = 0.f;
#pragma unroll
      for (int ww = 0; ww < 8; ++ww) { s1 += red[(ww * 64 + tid) * 2]; s2 += red[(ww * 64 + tid) * 2 + 1]; }
      float mean = s1 * (1.f / 1024.f); float var = s2 * (1.f / 1024.f) - mean * mean; var = var < 0.f ? 0.f : var;
      stat[tid * 2] = mean; stat[tid * 2 + 1] = rsqrtf(var + LN_EPS);
    }
    __syncthreads();
    const int lane2 = launder(lane); const int l31b = lane2 & 31, hhb = lane2 >> 5;
    float gg[4], bb[4];
#pragma unroll
    for (int nt = 0; nt < 4; ++nt) { int c = gcol0 + nt * 32 + l31b; gg[nt] = g[c]; bb[nt] = b[c]; }
    const unsigned base2 = (unsigned)((grow0 + 4 * hhb) * D_ + gcol0 + l31b);
#pragma unroll
    for (int mt = 0; mt < 2; ++mt)
#pragma unroll
      for (int i = 0; i < 16; ++i) {
        const int lr = mt * 32 + (i & 3) + 8 * (i >> 2) + 4 * hhb;
        const unsigned off = base2 + (unsigned)((mt * 32 + (i & 3) + 8 * (i >> 2)) * D_);
        const f32x2 st2 = *(const f32x2*)(stat + lr * 2);
#pragma unroll
        for (int nt = 0; nt < 4; ++nt) {
          float v = (acc[mt][nt][i] - st2.x) * st2.y * gg[nt] + bb[nt];
          Xout[off + nt * 32] = v; Xb[off + nt * 32] = f2bf(v);
        }
        asm volatile("" ::: "memory");
      }
  }
};

struct EpiLNX {
  const float* Xin; float* Xout; bf16_t* Xb; const float* bias; const float* cscale; const float* g; const float* b; float hs;
  u64_t* xstat; unsigned* xcnt; unsigned* tmo; unsigned target;
  DI void xpass(int ps, int grow0, int gcol0, int lane, int w, char* lds) const {
    char* xs = lds + (ps & 1) * 65536 + __builtin_amdgcn_readfirstlane(w) * 8192;
    const float* xsrc = Xin + (size_t)(grow0 + (ps >> 1) * 32 + (ps & 1) * 16 + (lane >> 5)) * D_ + gcol0 + (lane & 31) * 4;
#pragma unroll
    for (int pc = 0; pc < 8; ++pc)
      __builtin_amdgcn_global_load_lds((const unsigned*)(xsrc + (size_t)(2 * pc) * D_), (__attribute__((address_space(3))) unsigned*)(xs + pc * 1024), 16, 0, 0);
  }
  DI void pre(int grow0, int gcol0, int lane, int w, char* lds) { xpass(0, grow0, gcol0, lane, w, lds); }
  DI void operator()(f32x16 (&acc)[2][4], int grow0, int gcol0, int lane, int w, char* lds) {
    float* red = (float*)(lds + 131072); float* stat = (float*)lds;
    const int l31 = lane & 31, hh = lane >> 5, tid = w * 64 + lane;
    const int pm = grow0 >> 8, pn = gcol0 >> 8, wn = (gcol0 >> 7) & 1, lrow0 = grow0 & 255;
    float bia[4], csc[4];
#pragma unroll
    for (int nt = 0; nt < 4; ++nt) { int c = gcol0 + nt * 32 + l31; bia[nt] = bias ? bias[c] : 0.f; csc[nt] = cscale ? cscale[c] : 1.f; }
    float* redw = red + ((wn * 2 + ((lane >> 4) & 1)) * 256 + lrow0 + 4 * hh) * 2;
#pragma unroll
    for (int ps = 0; ps < 4; ++ps) {
      const int mt = ps >> 1;
      if (ps + 1 < 4) {
        if (ps >= 1) asm volatile("s_waitcnt lgkmcnt(0)" ::: "memory");
        xpass(ps + 1, grow0, gcol0, lane, w, lds);
        if (ps >= 1) asm volatile("s_waitcnt vmcnt(8)" ::: "memory");
      } else asm volatile("s_waitcnt vmcnt(0)" ::: "memory");
      const char* xs = lds + (ps & 1) * 65536 + w * 8192;
#pragma unroll
      for (int qq = 0; qq < 2; ++qq)
#pragma unroll
        for (int e = 0; e < 4; ++e) {
          const int i = 4 * (2 * (ps & 1) + qq) + e;
          const float* xr = (const float*)(xs + (8 * qq + 4 * hh + e) * 512) + l31;
          float s1 = 0.f, s2 = 0.f;
#pragma unroll
          for (int nt = 0; nt < 4; ++nt) {
            float v = (acc[mt][nt][i] + bia[nt]) * csc[nt];
            float z = ALPHA * xr[nt * 32] + hs * v;
            acc[mt][nt][i] = z; s1 += z; s2 += z * z;
          }
          s1 = row16_sum(s1); s2 = row16_sum(s2);
          if ((lane & 15) == 0) { f32x2 sv = {s1, s2}; *(f32x2*)(redw + (mt * 32 + (i & 3) + 8 * (i >> 2)) * 2) = sv; }
        }
    }
    __syncthreads();
    u64_t* myslots = xstat + ((size_t)pm * 256) * 4;
    if (tid < 256) {
      float s1 = (red[tid * 2] + red[(256 + tid) * 2]) + (red[(512 + tid) * 2] + red[(768 + tid) * 2]);
      float s2 = (red[tid * 2 + 1] + red[(256 + tid) * 2 + 1]) + (red[(512 + tid) * 2 + 1] + red[(768 + tid) * 2 + 1]);
      ag_st64(myslots + tid * 4 + pn, ((u64_t)__float_as_uint(s2) << 32) | (u64_t)__float_as_uint(s1));
    }
    asm volatile("s_waitcnt vmcnt(0)" ::: "memory");
    __syncthreads();
    if (tid == 0) {
      unsigned* c = xcnt + pm * 64;
      ag_add32(c, 1u);
      unsigned sp = 0;
      while (ag_ld32(c) < target) {
        __builtin_amdgcn_s_sleep(1);
        if ((++sp & 255u) == 0u) { if (ag_ld32(tmo)) break; if (sp > (1u << 20)) { atomicAdd(tmo, 1u); break; } }
      }
    }
    __syncthreads();
    if (tid < 256) {
      float s1 = 0.f, s2 = 0.f;
#pragma unroll
      for (int q = 0; q < 4; ++q) { u64_t v = ag_ld64(myslots + tid * 4 + q); s1 += __uint_as_float((unsigned)v); s2 += __uint_as_float((unsigned)(v >> 32)); }
      float mean = s1 * (1.f / 1024.f); float var = s2 * (1.f / 1024.f) - mean * mean; var = var < 0.f ? 0.f : var;
      f32x2 sv = {mean, rsqrtf(var + LN_EPS)}; *(f32x2*)(stat + tid * 2) = sv;
    }
    __syncthreads();
    const int lane2 = launder(lane); const int l31b = lane2 & 31, hhb = lane2 >> 5;
    float gg[4], bb[4];
#pragma unroll
    for (int nt = 0; nt < 4; ++nt) { int c = gcol0 + nt * 32 + l31b; gg[nt] = g[c]; bb[nt] = b[c]; }
    const unsigned base2 = (unsigned)((grow0 + 4 * hhb) * D_ + gcol0 + l31b);
#pragma unroll
    for (int mt = 0; mt < 2; ++mt)
#pragma unroll
      for (int i = 0; i < 16; ++i) {
        const int lr = lrow0 + mt * 32 + (i & 3) + 8 * (i >> 2) + 4 * hhb;
        const unsigned off = base2 + (unsigned)((mt * 32 + (i & 3) + 8 * (i >> 2)) * D_);
        const f32x2 st2 = *(const f32x2*)(stat + lr * 2);
#pragma unroll
        for (int nt = 0; nt < 4; ++nt) {
          float v = (acc[mt][nt][i] - st2.x) * st2.y * gg[nt] + bb[nt];
          Xout[off + nt * 32] = v; Xb[off + nt * 32] = f2bf(v);
        }
        asm volatile("" ::: "memory");
      }
  }
};

DI void store_tr(bf16_t* dstrow, int tok0, const f32x16& v, int hh, float mul) {
#pragma unroll
  for (int qd = 0; qd < 4; ++qd) {
    u32x2 p; p.x = pack2(v[4 * qd] * mul, v[4 * qd + 1] * mul); p.y = pack2(v[4 * qd + 2] * mul, v[4 * qd + 3] * mul);
    *(u32x2*)(dstrow + tok0 + 8 * qd + 4 * hh) = p;
  }
}

DI char* tr_stage(char* lds, int w) { return lds + 65536 + w * 8192; }
DI void tr_put(char* stg, int erow, const f32x16& v, int hh, float mul) {
#pragma unroll
  for (int qd = 0; qd < 4; ++qd) {
    u32x2 pk; pk.x = pack2(v[4 * qd] * mul, v[4 * qd + 1] * mul); pk.y = pack2(v[4 * qd + 2] * mul, v[4 * qd + 3] * mul);
    *(u32x2*)(stg + erow * 64 + (8 * qd + 4 * hh) * 2) = pk;
  }
}
template <int R>
DI void tr_flush(const char* stg, int row0, bf16_t* g, size_t grs, int lane) {
  const int r0 = lane >> 2, ch = lane & 3;
#pragma unroll
  for (int it = 0; it < R / 16; ++it) {
    const int r = it * 16 + r0;
    u32x4 v = *(const u32x4*)(stg + (row0 + r) * 64 + ch * 16);
    *(u32x4*)((char*)(g + (size_t)r * grs) + ch * 16) = v;
  }
}

struct EpiDAqkv {
  DI void pre(int, int, int, int, char*) {}
  bf16_t *Q, *K, *Vt; const float *cs, *sn;
  DI void operator()(f32x16 (&acc)[2][4], int grow0, int gcol0, int lane, int w, char* lds) {
    const int l31 = lane & 31, hh = lane >> 5;
    const int part = gcol0 >> 10, cin = gcol0 & 1023;
    if (part < 2) {
      bf16_t* dst = part == 0 ? Q : K;
#pragma unroll
      for (int mt = 0; mt < 2; ++mt)
#pragma unroll
        for (int pr = 0; pr < 2; ++pr)
#pragma unroll
          for (int i = 0; i < 16; ++i) {
            int row = grow0 + mt * 32 + crow(i, hh);
            float c = cs[row * 32 + l31], s = sn[row * 32 + l31];
            float x1 = acc[mt][2 * pr][i], x2 = acc[mt][2 * pr + 1][i];
            int col = cin + pr * 64 + l31;
            dst[(size_t)row * D_ + col] = f2bf(x1 * c - x2 * s);
            dst[(size_t)row * D_ + col + 32] = f2bf(x2 * c + x1 * s);
          }
    } else {
      const int b = grow0 >> 11, s0 = grow0 & 2047, h = cin >> 7;
      char* stg = tr_stage(lds, w);
#pragma unroll
      for (int mt = 0; mt < 2; ++mt) {
#pragma unroll
        for (int nt = 0; nt < 4; ++nt) tr_put(stg, nt * 32 + l31, acc[mt][nt], hh, 1.f);
        tr_flush<128>(stg, 0, Vt + ((size_t)(b * 8 + h) * 128) * S_ + s0 + mt * 32, S_, lane);
      }
    }
  }
};

struct EpiRETqkvg {
  DI void pre(int, int, int, int, char*) {}
  bf16_t *Q, *K, *Kdt, *Vrt, *G; const float *cs, *sn;
  DI void operator()(f32x16 (&acc)[2][4], int grow0, int gcol0, int lane, int w, char* lds) {
    const int l31 = lane & 31, hh = lane >> 5;
    const int b = grow0 >> 11, s0 = grow0 & 2047;
    if (gcol0 < 2048) {
      const int part = gcol0 >> 10, cin = gcol0 & 1023, h = cin >> 8, p0 = (cin & 255) >> 6;
      const float lg = logf(1.f - ex2(-5.f - (float)h));
      bf16_t* dst = part == 0 ? Q : K;
      const float mul = part == 0 ? 1.f : 0.0625f;
#pragma unroll
      for (int pr = 0; pr < 2; ++pr) {
        const int d = 32 * (p0 + pr) + l31;
        bf16_t* r1 = Kdt + ((size_t)(b * 4 + h) * 256 + d) * S_ + s0;
#pragma unroll
        for (int mt = 0; mt < 2; ++mt) {
          float c16[16], s16[16];
#pragma unroll
          for (int i = 0; i < 16; ++i) { const unsigned to = (unsigned)((grow0 + mt * 32 + crow(i, hh)) * 128 + d); c16[i] = cs[to]; s16[i] = sn[to]; }
#pragma unroll
          for (int qd = 0; qd < 4; ++qd) {
            float o1[4], o2[4];
#pragma unroll
            for (int e = 0; e < 4; ++e) {
              const int i = 4 * qd + e;
              const int row = grow0 + mt * 32 + 8 * qd + 4 * hh + e;
              float c = c16[i], s = s16[i];
              float x1 = acc[mt][2 * pr][i], x2 = acc[mt][2 * pr + 1][i];
              o1[e] = (x1 * c - x2 * s) * mul; o2[e] = (x2 * c + x1 * s) * mul;
              const unsigned oo = (unsigned)(row * D_ + h * 256 + d);
              dst[oo] = f2bf(o1[e]); dst[oo + 128] = f2bf(o2[e]);
            }
            if (part == 1) {
              const int rl = (mt * 32 + 8 * qd + 4 * hh) & 127;
              const int rb = (grow0 & 127) + rl;
#pragma unroll
              for (int e = 0; e < 4; ++e) { float kd = __expf((float)(127 - (rb + e)) * lg); o1[e] *= kd; o2[e] *= kd; }
              u32x2 p1, p2; p1.x = pack2(o1[0], o1[1]); p1.y = pack2(o1[2], o1[3]); p2.x = pack2(o2[0], o2[1]); p2.y = pack2(o2[2], o2[3]);
              *(u32x2*)(r1 + mt * 32 + 8 * qd + 4 * hh) = p1;
              *(u32x2*)(r1 + (size_t)128 * S_ + mt * 32 + 8 * qd + 4 * hh) = p2;
            }
          }
          asm volatile("" ::: "memory");
        }
      }
    } else if (gcol0 < 4096) {
      const int cin = gcol0 - 2048, h = cin >> 9;
      char* stg = tr_stage(lds, w);
#pragma unroll
      for (int mt = 0; mt < 2; ++mt) {
#pragma unroll
        for (int nt = 0; nt < 4; ++nt) tr_put(stg, nt * 32 + l31, acc[mt][nt], hh, 1.f);
        tr_flush<128>(stg, 0, Vrt + ((size_t)(b * 4 + h) * 512 + (cin & 511)) * S_ + s0 + mt * 32, S_, lane);
      }
    } else {
      const int cin = gcol0 - 4096;
#pragma unroll
      for (int mt = 0; mt < 2; ++mt)
#pragma unroll
        for (int nt = 0; nt < 4; ++nt)
#pragma unroll
          for (int i = 0; i < 16; ++i) { int row = grow0 + mt * 32 + crow(i, hh); G[(size_t)row * 2048 + cin + nt * 32 + l31] = f2bf(acc[mt][nt][i]); }
    }
  }
};

struct EpiPlain {
  DI void pre(int, int, int, int, char*) {}
  bf16_t* dst; float mul;
  DI void operator()(f32x16 (&acc)[2][4], int grow0, int gcol0, int lane, int w, char* lds) {
    const int l31 = lane & 31, hh = lane >> 5;
#pragma unroll
    for (int mt = 0; mt < 2; ++mt)
#pragma unroll
      for (int nt = 0; nt < 4; ++nt)
#pragma unroll
        for (int i = 0; i < 16; ++i) { int row = grow0 + mt * 32 + crow(i, hh); dst[(size_t)row * D_ + gcol0 + nt * 32 + l31] = f2bf(acc[mt][nt][i] * mul); }
  }
};

struct EpiXkv {
  DI void pre(int, int, int, int, char*) {}
  bf16_t *Kx, *Vxt;
  DI void operator()(f32x16 (&acc)[2][4], int grow0, int gcol0, int lane, int w, char* lds) {
    const int l31 = lane & 31, hh = lane >> 5;
    if (gcol0 < 1024) {
#pragma unroll
      for (int mt = 0; mt < 2; ++mt)
#pragma unroll
        for (int nt = 0; nt < 4; ++nt)
#pragma unroll
          for (int i = 0; i < 16; ++i) { int row = grow0 + mt * 32 + crow(i, hh); Kx[(size_t)row * D_ + gcol0 + nt * 32 + l31] = f2bf(acc[mt][nt][i]); }
    } else {
      const int cin = gcol0 - 1024, h = cin >> 8, b = grow0 >> 8, m0 = grow0 & 255;
      char* stg = tr_stage(lds, w);
#pragma unroll
      for (int mt = 0; mt < 2; ++mt) {
#pragma unroll
        for (int nt = 0; nt < 4; ++nt) tr_put(stg, nt * 32 + l31, acc[mt][nt], hh, 1.f);
        tr_flush<128>(stg, 0, Vxt + ((size_t)(b * 4 + h) * 256 + (cin & 255)) * 256 + m0 + mt * 32, 256, lane);
      }
    }
  }
};

template <class Epi>
DI void gemm_phase256(const bf16_t* A, int lda, const bf16_t* Bt, int K, int nN, char* lds, Epi& epi, int vb) {
  const int ntiles = 64 * nN;
  bool pre = false;
  for (int t = vb; t < ntiles; t += gridDim.x) {
    const int x = t & 7, L = t >> 3; const int pm = 8 * x + (L & 7), pn = L >> 3;
    const int t2 = t + gridDim.x; const bool hn = t2 < ntiles;
    const int x2 = t2 & 7, L2 = t2 >> 3; const int pm2 = 8 * x2 + (L2 & 7), pn2 = L2 >> 3;
    gemm_tile<4, 64>(A, lda, Bt, K, K, pm * 256, pn * 256, lds, epi, pre, hn, pm2 * 256, pn2 * 256);
    pre = hn;
  }
}
template <class Epi>
DI void gemm_phaseLNX(const bf16_t* A, int K, const bf16_t* Bt, char* lds, Epi& epi, int vb, bool blockdiag = false) {
  const int t = vb; const int x = t & 7, L = t >> 3; const int pm = 8 * x + (L & 7), pn = L >> 3;
  if (blockdiag) gemm_tile<4, 64>(A + pn * 256, K, Bt + pn * 256, K, 256, pm * 256, pn * 256, lds, epi);
  else gemm_tile<4, 64>(A, K, Bt, K, K, pm * 256, pn * 256, lds, epi);
}
template <class Epi>
DI void gemm_phaseLN(const bf16_t* A, int K, const bf16_t* Bt, char* lds, Epi& epi) {
  for (int t = blockIdx.x; t < 256; t += gridDim.x) gemm_tile<1, 32>(A, K, Bt, K, K, t * 64, 0, lds, epi);
}

DI int src_col(int perm, int n) {
  if (perm == 1) { int p = n >> 6, r = n & 63; return r < 32 ? 32 * p + r : 2816 + 32 * p + (r - 32); }
  if (perm == 3) {
    if (n >= 2048) return n;
    int part = n >> 10, h = (n & 1023) >> 8, n2 = n & 255, p = n2 >> 6, r = n2 & 63;
    int d = r < 32 ? 32 * p + r : 128 + 32 * p + (r - 32);
    return part * 1024 + h * 256 + d;
  }
  return n;
}

DI void phase_prologue(const Params& p, char* lds) {
  const int tid = launder(threadIdx.x);
  float* tile = (float*)lds;
  const int total = p.tile_start[p.njobs];
  int j = 0;
  for (int t = blockIdx.x; t < total; t += gridDim.x) {
    while (j + 1 < p.njobs && t >= p.tile_start[j + 1]) ++j;
    const TJob& jb = p.jobs[j];
    const int lt = t - p.tile_start[j];
    const int nkt = jb.K >> 7;
    const int k0 = (lt % nkt) << 7, n0 = (lt / nkt) << 7;
    __syncthreads();
    {
      const int nl = tid & 127, kb = tid >> 7;
      const int n = n0 + nl;
      if (jb.perm == 4) {
        const int g = n >> 8, gk = k0 >> 8;
#pragma unroll 8
        for (int i = 0; i < 32; ++i) { int kl = kb + 4 * i; int k = k0 + kl; tile[kl * 129 + nl] = (g == gk) ? jb.src[(size_t)g * 65536 + (size_t)(k & 255) * 256 + (n & 255)] : 0.f; }
      } else {
        const int sc = src_col(jb.perm, n);
        const float* sp = jb.src + (size_t)k0 * jb.lds_ + sc;
#pragma unroll 16
        for (int i = 0; i < 32; ++i) { int kl = kb + 4 * i; tile[kl * 129 + nl] = sp[(size_t)kl * jb.lds_]; }
      }
    }
    __syncthreads();
    {
      const int kl = tid & 127, nb = tid >> 7;
#pragma unroll 16
      for (int i = 0; i < 32; ++i) { int nl = nb + 4 * i; jb.dst[(size_t)(n0 + nl) * jb.ldd + k0 + kl] = f2bf(tile[kl * 129 + nl]); }
    }
  }
  const size_t gtid = (size_t)blockIdx.x * NT + tid, gsz = (size_t)gridDim.x * NT;
  for (size_t i = gtid; i < (size_t)T_ * D_ / 4; i += gsz) {
    f32x4 v = ((const f32x4*)p.x)[i];
    u32x2 o; o.x = pack2(v[0], v[1]); o.y = pack2(v[2], v[3]); ((u32x2*)p.Xb)[i] = o;
  }
  for (size_t i = gtid; i < (size_t)2048 * D_ / 4; i += gsz) {
    f32x4 v = ((const f32x4*)p.mem)[i];
    u32x2 o; o.x = pack2(v[0], v[1]); o.y = pack2(v[2], v[3]); ((u32x2*)p.memb)[i] = o;
  }
  const double TWO_PI = 6.283185307179586476925286766559;
  const double L2T = 13.287712379549449391481277717958;
  for (size_t i = gtid; i < (size_t)T_ * 32; i += gsz) {
    int t = (int)(i >> 5), k = (int)(i & 31);
    double inv = exp2(-(double)k * (1.0 / 32.0) * L2T);
    double ang = (double)p.pos[t] * inv; ang -= TWO_PI * rint(ang * (1.0 / TWO_PI));
    float a = (float)ang; p.cosD[i] = cosf(a); p.sinD[i] = sinf(a);
  }
  for (size_t i = gtid; i < (size_t)T_ * 128; i += gsz) {
    int t = (int)(i >> 7), k = (int)(i & 127);
    double inv = exp2(-(double)k * (1.0 / 127.0) * L2T);
    double ang = (double)p.pos[t] * inv; ang -= TWO_PI * rint(ang * (1.0 / TWO_PI));
    float a = (float)ang; p.cosR[i] = cosf(a); p.sinR[i] = sinf(a);
  }
}

template <int VSTR, bool DEFER = false>
DI void softmax_pv(f32x16 (&st)[2], float& m, float& l, f32x16 (&o)[4], const char* vt, int erow0, int lane) {
  const int l31 = lane & 31, hh = lane >> 5;
  float mx = -1e30f;
#pragma unroll
  for (int mt = 0; mt < 2; ++mt)
#pragma unroll
    for (int i = 0; i < 16; ++i) mx = fmaxf(mx, st[mt][i]);
  mx = xhalf_max(mx);
  if (DEFER) {
    constexpr float THR = 6.0f;
    if (__any(mx > m + THR)) {
      const float mn = fmaxf(m, mx);
      const float al = ex2(m - mn);
      m = mn;
      l *= al;
#pragma unroll
      for (int et = 0; et < 4; ++et)
#pragma unroll
        for (int i = 0; i < 16; ++i) o[et][i] *= al;
    }
    float ps = 0.f;
#pragma unroll
    for (int mt = 0; mt < 2; ++mt)
#pragma unroll
      for (int i = 0; i < 16; ++i) { float pv = ex2(st[mt][i] - m); st[mt][i] = pv; ps += pv; }
    l += ps;
  } else {
    const float mn = fmaxf(m, mx);
    const float al = ex2(m - mn);
    m = mn;
    float ps = 0.f;
#pragma unroll
    for (int mt = 0; mt < 2; ++mt)
#pragma unroll
      for (int i = 0; i < 16; ++i) { float pv = ex2(st[mt][i] - mn); st[mt][i] = pv; ps += pv; }
    l = l * al + ps;
#pragma unroll
    for (int et = 0; et < 4; ++et)
#pragma unroll
      for (int i = 0; i < 16; ++i) o[et][i] *= al;
  }
#pragma unroll
  for (int mt = 0; mt < 2; ++mt)
#pragma unroll
    for (int s = 0; s < 2; ++s) {
      u32x4 pb; pb.x = pack2(st[mt][8 * s], st[mt][8 * s + 1]); pb.y = pack2(st[mt][8 * s + 2], st[mt][8 * s + 3]);
      pb.z = pack2(st[mt][8 * s + 4], st[mt][8 * s + 5]); pb.w = pack2(st[mt][8 * s + 6], st[mt][8 * s + 7]);
      const bf16x8 bfrag = __builtin_bit_cast(bf16x8, pb);
      const int kb = mt * 32 + 16 * s + 4 * hh;
#pragma unroll
      for (int et = 0; et < 4; ++et) {
        const char* rp = vt + (erow0 + et * 32 + l31) * VSTR + kb * 2;
        s16x4 lo = *(const s16x4*)rp, hi = *(const s16x4*)(rp + 16);
        bf16x8 afrag = __builtin_shufflevector(lo, hi, 0, 1, 2, 3, 4, 5, 6, 7);
        o[et] = mfma(afrag, bfrag, o[et]);
      }
    }
}


DI f32x16 dot16_lds(const char* img, int row, int hh, const bf16x8 (&qf)[16], f32x16 acc) {
  const char* rp = img + row * 512; const int r15 = row & 15;
  bf16x8 a[2][4];
#pragma unroll
  for (int q = 0; q < 4; ++q) a[0][q] = *(const bf16x8*)(rp + ((((q * 2) + hh) ^ r15) << 4));
#pragma unroll
  for (int g = 0; g < 4; ++g) {
    if (g + 1 < 4) {
#pragma unroll
      for (int q = 0; q < 4; ++q) a[(g + 1) & 1][q] = *(const bf16x8*)(rp + (((((g + 1) * 4 + q) * 2 + hh) ^ r15) << 4));
    }
#pragma unroll
    for (int q = 0; q < 4; ++q) acc = mfma(a[g & 1][q], qf[g * 4 + q], acc);
    __builtin_amdgcn_sched_barrier(0);
  }
  return acc;
}
DI void phase_da_attn(const Params& p, int j, char* lds) {
  const int tid = launder(threadIdx.x), lane = tid & 63, w = tid >> 6, l31 = lane & 31, hh = lane >> 5;
  const int c = w & 1, qg = w >> 1;
  constexpr int KVB = 33792;
  float* cmb = (float*)(lds + 2 * KVB);
  float lam;
  {
    const float* lq = p.lam_q + j * 128; const float* lk = p.lam_k + j * 128;
    float v0 = lq[lane] * lk[lane], v1 = lq[64 + lane] * lk[64 + lane];
#pragma unroll
    for (int o = 32; o > 0; o >>= 1) { v0 += __shfl_xor(v0, o); v1 += __shfl_xor(v1, o); }
    lam = __expf(v0) - __expf(v1) + p.lam_init[j];
  }
  const float li = p.lam_init[j];
  const float sc = 0.125f * LOG2E;
  const bf16_t* Q = p.Q; const bf16_t* K = p.Kb; const bf16_t* Vt = p.Vt;
  for (int it = blockIdx.x; it < 1024; it += gridDim.x) {
    const int jj = it & 255, kr = it >> 8, g = jj >> 6, bh = jj & 63;
    const int qb = kr == 0 ? 15 - g : kr == 1 ? 8 + g : kr == 2 ? 7 - g : g;
    const int b = bh >> 3, h = bh & 7;
    const int q0 = qb * 128 + qg * 32;
    const int myq = q0 + l31;
    const size_t tokb = (size_t)b * S_;
    bf16x8 qf[4];
#pragma unroll
    for (int kk = 0; kk < 4; ++kk) qf[kk] = *(const bf16x8*)(Q + (tokb + myq) * D_ + h * 128 + c * 64 + kk * 16 + 8 * hh);
    f32x16 o[4];
#pragma unroll
    for (int et = 0; et < 4; ++et) o[et] = zero16();
    float m = -1e30f, l = 0.f;
    const int nkt = 2 * (qb + 1);
    u32x4 rk[2], rv[2];
    auto gload = [&](int kt) {
#pragma unroll
      for (int i = 0; i < 2; ++i) {
        int idx = tid + i * NT;
        { int row = idx >> 4, ch = idx & 15; rk[i] = *(const u32x4*)(K + (tokb + kt * 64 + row) * D_ + h * 128 + ch * 8); }
        { int row = idx >> 3, ch = idx & 7; rv[i] = *(const u32x4*)(Vt + ((size_t)(b * 8 + h) * 128 + row) * S_ + kt * 64 + ch * 8); }
      }
    };
    auto lwrite = [&](int buf) {
      char* kt_w = lds + buf * KVB; char* vt_w = kt_w + 16384;
#pragma unroll
      for (int i = 0; i < 2; ++i) {
        int idx = tid + i * NT;
        { int row = idx >> 4, ch = idx & 15; *(u32x4*)(kt_w + row * 256 + ((ch ^ (row & 15)) << 4)) = rk[i]; }
        { int row = idx >> 3, ch = idx & 7; char* d = vt_w + row * 136 + ch * 16; u32x2 a = {rv[i].x, rv[i].y}, bq = {rv[i].z, rv[i].w}; *(u32x2*)d = a; *(u32x2*)(d + 8) = bq; }
      }
    };
    __syncthreads();
    gload(0); lwrite(0);
    if (nkt > 1) gload(1);
    __syncthreads();
    for (int kt = 0; kt < nkt; ++kt) {
      if (kt + 1 < nkt) lwrite((kt + 1) & 1);
      if (kt + 2 < nkt) gload(kt + 2);
      const char* kt_l = lds + (kt & 1) * KVB; const char* vt_l = kt_l + 16384;
      if (kt * 64 <= q0 + 31) {
        f32x16 st[2];
#pragma unroll
        for (int mt = 0; mt < 2; ++mt) {
          st[mt] = zero16();
          const int row = mt * 32 + l31;
#pragma unroll
          for (int kk = 0; kk < 4; ++kk) {
            int ch = c * 8 + kk * 2 + hh;
            bf16x8 a = *(const bf16x8*)(kt_l + row * 256 + ((ch ^ (row & 15)) << 4));
            st[mt] = mfma(a, qf[kk], st[mt]);
          }
        }
        const bool diag = kt * 64 + 63 > q0;
#pragma unroll
        for (int mt = 0; mt < 2; ++mt)
#pragma unroll
          for (int i = 0; i < 16; ++i) {
            float s = st[mt][i] * sc;
            if (diag) { int key = kt * 64 + mt * 32 + crow(i, hh); if (key > myq) s = -1e30f; }
            st[mt][i] = s;
          }
        softmax_pv<136, true>(st, m, l, o, vt_l, 0, lane);
      }
      __syncthreads();
    }
    l = xhalf_sum(l);
    const float inv = 1.f / l;
    if (c == 1) {
#pragma unroll
      for (int et = 0; et < 4; ++et)
#pragma unroll
        for (int i = 0; i < 16; ++i) cmb[(qg * 128 + et * 32 + crow(i, hh)) * 32 + l31] = o[et][i] * inv;
    }
    __syncthreads();
    if (c == 0) {
      float ss = 0.f;
#pragma unroll
      for (int et = 0; et < 4; ++et)
#pragma unroll
        for (int i = 0; i < 16; ++i) { float v = o[et][i] * inv - lam * cmb[(qg * 128 + et * 32 + crow(i, hh)) * 32 + l31]; o[et][i] = v; ss += v * v; }
      ss = xhalf_sum(ss);
      const float r = rsqrtf(ss * (1.f / 128.f) + LN_EPS) * (1.f - li);
      bf16_t* orow = p.Oa + (tokb + myq) * D_ + h * 128;
      const float* sg = p.subln_g + j * 128;
#pragma unroll
      for (int et = 0; et < 4; ++et)
#pragma unroll
        for (int qd = 0; qd < 4; ++qd) {
          int e = et * 32 + 8 * qd + 4 * hh;
          f32x4 gv = *(const f32x4*)(sg + e);
          u32x2 pk; pk.x = pack2(o[et][4 * qd] * r * gv[0], o[et][4 * qd + 1] * r * gv[1]); pk.y = pack2(o[et][4 * qd + 2] * r * gv[2], o[et][4 * qd + 3] * r * gv[3]);
          *(u32x2*)(orow + e) = pk;
        }
    }
  }
}

DI void phase_xa_attn(const Params& p, int layer, char* lds) {
  const int tid = launder(threadIdx.x), lane = tid & 63, w = tid >> 6, l31 = lane & 31, hh = lane >> 5;
  const int eh = w & 1, qg = w >> 1;
  const bf16_t* Q = p.Q; const bf16_t* K = p.Kx + (size_t)layer * 2048 * D_; const bf16_t* Vt = p.Vxt + (size_t)layer * 32 * 256 * 256;
  for (int it = blockIdx.x; it < 512; it += gridDim.x) {
    const int xq = it & 7, li = ((it >> 3) & 31) + 32 * (it >> 8);
    const int bhx = xq * 4 + (li >> 4); const int b = bhx >> 2, h = bhx & 3, qt = b * 16 + (li & 15);
    const size_t tok = (size_t)qt * 128 + qg * 32 + l31;
    bf16x8 qf[16];
#pragma unroll
    for (int kk = 0; kk < 16; ++kk) qf[kk] = *(const bf16x8*)(Q + tok * D_ + h * 256 + kk * 16 + 8 * hh);
    f32x16 o[4];
#pragma unroll
    for (int et = 0; et < 4; ++et) o[et] = zero16();
    float m = -1e30f, l = 0.f;
    u32x4 rv[4];
    auto kdma = [&](int kt) {
      char* kb = lds + (kt & 1) * 32768;
#pragma unroll 1
      for (int i = 0; i < 4; ++i) {
        const int pc = __builtin_amdgcn_readfirstlane(w) * 4 + i; const int row = 2 * pc + (lane >> 5); const int cc = (lane & 31) ^ (row & 15);
        __builtin_amdgcn_global_load_lds((const unsigned*)(K + ((size_t)b * 256 + kt * 64 + row) * D_ + h * 256 + cc * 8), (__attribute__((address_space(3))) unsigned*)(kb + pc * 1024), 16, 0, 0);
      }
    };
    auto vload = [&](int kt) {
#pragma unroll
      for (int i = 0; i < 4; ++i) { int idx = tid + i * NT; int row = idx >> 3, ch = idx & 7; rv[i] = *(const u32x4*)(Vt + ((size_t)(b * 4 + h) * 256 + row) * 256 + kt * 64 + ch * 8); }
    };
    auto vwrite = [&](int kt) {
      char* vb_ = lds + 65536 + (kt & 1) * 34816;
#pragma unroll
      for (int i = 0; i < 4; ++i) { int idx = tid + i * NT; int row = idx >> 3, ch = idx & 7; char* d = vb_ + row * 136 + ch * 16; u32x2 a = {rv[i].x, rv[i].y}, bq = {rv[i].z, rv[i].w}; *(u32x2*)d = a; *(u32x2*)(d + 8) = bq; }
    };
    __syncthreads();
    kdma(0); vload(0); vwrite(0);
    wait_vm0();
    __syncthreads();
    for (int kt = 0; kt < 4; ++kt) {
      if (kt + 1 < 4) kdma(kt + 1);
      const char* kt_l = lds + (kt & 1) * 32768; const char* vt_l = lds + 65536 + (kt & 1) * 34816;
      f32x16 st[2];
      const int l31k = launder(l31);
#pragma unroll
      for (int mt = 0; mt < 2; ++mt) {
        st[mt] = dot16_lds(kt_l, mt * 32 + l31k, hh, qf, zero16());
      }
#pragma unroll
      for (int mt = 0; mt < 2; ++mt)
#pragma unroll
        for (int i = 0; i < 16; ++i) st[mt][i] *= LOG2E;
      softmax_pv<136>(st, m, l, o, vt_l, eh * 128, lane);
      if (kt + 1 < 4) { vload(kt + 1); vwrite(kt + 1); }
      wait_vm0();
      __syncthreads();
    }
    l = xhalf_sum(l);
    const float inv = 1.f / l;
    char* stg = lds + w * 8704;
#pragma unroll
    for (int et = 0; et < 4; ++et)
#pragma unroll
      for (int qd = 0; qd < 4; ++qd) {
        int e = et * 32 + 8 * qd + 4 * hh;
        u32x2 pk; pk.x = pack2(o[et][4 * qd] * inv, o[et][4 * qd + 1] * inv); pk.y = pack2(o[et][4 * qd + 2] * inv, o[et][4 * qd + 3] * inv);
        *(u32x2*)(stg + l31 * 272 + e * 2) = pk;
      }
    {
      bf16_t* obase = p.Oa + ((size_t)qt * 128 + qg * 32) * D_ + h * 256 + eh * 128;
      const int r0 = lane >> 4, ch = lane & 15;
#pragma unroll 2
      for (int it = 0; it < 8; ++it) {
        const int r = it * 4 + r0;
        u32x4 v = *(const u32x4*)(stg + r * 272 + ch * 16);
        *(u32x4*)(obase + (size_t)r * D_ + ch * 8) = v;
      }
    }
  }
}

DI void phase_ret(const Params& p, char* lds) {
  const int tid = launder(threadIdx.x), lane = tid & 63, w = tid >> 6, l31 = lane & 31, hh = lane >> 5;
  char* k_l = lds;
  char* v_l = lds + 65536;
  char* r_l = lds + 65536 + 16896;
  const int et = w & 1, itl = w >> 1;
  for (int it = blockIdx.x; it < 256; it += gridDim.x) {
    const int xq = it & 7, rq = it >> 3;
    const int sl = rq & 7, bh = xq * 4 + (rq >> 3), b = bh >> 2, h = bh & 3;
    const float lg = logf(1.f - ex2(-5.f - (float)h));
    const float lg2 = lg * LOG2E;
    const float cd = ex2(128.f * lg2);
    const size_t tokb = (size_t)b * S_;
    f32x16 R[2]; R[0] = zero16(); R[1] = zero16();
    const int myi = itl * 32 + l31;
    const float qd = ex2((float)(myi + 1) * lg2);
    for (int ck = 0; ck < 16; ++ck) {
      const int s0 = ck * 128;
      const int l31k = launder(l31), hhk = launder(hh);
      __syncthreads();
#pragma unroll 1
      for (int i = 0; i < 8; ++i) {
        const int pc = __builtin_amdgcn_readfirstlane(w) * 8 + i; const int row = 2 * pc + (lane >> 5); const int c = (lane & 31) ^ (row & 15);
        __builtin_amdgcn_global_load_lds((const unsigned*)(p.Kb + (tokb + s0 + row) * D_ + h * 256 + c * 8), (__attribute__((address_space(3))) unsigned*)(k_l + pc * 1024), 16, 0, 0);
      }
#pragma unroll
      for (int i = 0; i < 2; ++i) {
        int idx = tid + i * NT; int row = idx >> 4, ch = idx & 15;
        u32x4 v = *(const u32x4*)(p.Vrt + ((size_t)bh * 512 + sl * 64 + row) * S_ + s0 + ch * 8);
        char* d = v_l + row * 264 + ch * 16; u32x2 a = {v.x, v.y}, bq = {v.z, v.w}; *(u32x2*)d = a; *(u32x2*)(d + 8) = bq;
      }
      bf16x8 qf[16];
#pragma unroll
      for (int kk = 0; kk < 16; ++kk) qf[kk] = *(const bf16x8*)(p.Q + (tokb + s0 + myi) * D_ + h * 256 + kk * 16 + 8 * hhk);
      wait_vm0();
      __syncthreads();
      f32x16 o = zero16();
      if (ck > 0) {
        o = dot16_lds(r_l, et * 32 + l31k, hhk, qf, o);
#pragma unroll
        for (int i = 0; i < 16; ++i) o[i] *= qd;
      }
      for (int jt = 0; jt <= itl; ++jt) {
        f32x16 st = zero16();
        const int relb = launder(itl * 32 + l31k - jt * 32 - 4 * hhk);
        st = dot16_lds(k_l, jt * 32 + l31k, hhk, qf, st);
#pragma unroll
        for (int i = 0; i < 16; ++i) { int rel = relb - ((i & 3) + 8 * (i >> 2)); st[i] = rel >= 0 ? st[i] * ex2((float)rel * lg2) : 0.f; }
#pragma unroll
        for (int s = 0; s < 2; ++s) {
          u32x4 pb; pb.x = pack2(st[8 * s], st[8 * s + 1]); pb.y = pack2(st[8 * s + 2], st[8 * s + 3]); pb.z = pack2(st[8 * s + 4], st[8 * s + 5]); pb.w = pack2(st[8 * s + 6], st[8 * s + 7]);
          const bf16x8 bfrag = __builtin_bit_cast(bf16x8, pb);
          const char* rp = v_l + (et * 32 + l31k) * 264 + (jt * 32 + 16 * s + 4 * hhk) * 2;
          s16x4 lo = *(const s16x4*)rp, hi = *(const s16x4*)(rp + 16);
          bf16x8 afrag = __builtin_shufflevector(lo, hi, 0, 1, 2, 3, 4, 5, 6, 7);
          o = mfma(afrag, bfrag, o);
        }
      }
      {
        bf16_t* orow = p.Or + (tokb + s0 + myi) * 2048 + h * 512 + sl * 64 + et * 32;
#pragma unroll
        for (int q4 = 0; q4 < 4; ++q4) {
          u32x2 pk; pk.x = pack2(o[4 * q4], o[4 * q4 + 1]); pk.y = pack2(o[4 * q4 + 2], o[4 * q4 + 3]);
          *(u32x2*)(orow + 8 * q4 + 4 * hhk) = pk;
        }
      }
      asm volatile("" ::: "memory");
      if (ck < 15) {
        const bf16_t* kdr = p.Vt + ((size_t)bh * 256 + w * 32 + l31k) * S_ + s0;
        bf16x8 ka[8];
#pragma unroll
        for (int kk = 0; kk < 8; ++kk) ka[kk] = *(const bf16x8*)(kdr + kk * 16 + 8 * hhk);
#pragma unroll
        for (int nt = 0; nt < 2; ++nt) {
#pragma unroll
          for (int i = 0; i < 16; ++i) R[nt][i] *= cd;
#pragma unroll
          for (int kk = 0; kk < 8; ++kk) {
            const char* rp = v_l + (nt * 32 + l31k) * 264 + (kk * 16 + 8 * hhk) * 2;
            s16x4 lo = *(const s16x4*)rp, hi = *(const s16x4*)(rp + 8);
            bf16x8 bfrag = __builtin_shufflevector(lo, hi, 0, 1, 2, 3, 4, 5, 6, 7);
            R[nt] = mfma(ka[kk], bfrag, R[nt]);
          }
        }
        __syncthreads();
#pragma unroll
        for (int nt = 0; nt < 2; ++nt) {
          const int e = nt * 32 + l31k;
#pragma unroll
          for (int q4 = 0; q4 < 4; ++q4) {
            int d = w * 32 + 8 * q4 + 4 * hhk;
            u32x2 pk; pk.x = pack2(R[nt][4 * q4], R[nt][4 * q4 + 1]); pk.y = pack2(R[nt][4 * q4 + 2], R[nt][4 * q4 + 3]);
            *(u32x2*)(r_l + e * 512 + (((d >> 3) ^ (e & 15)) << 4) + (d & 7) * 2) = pk;
          }
        }
      }
    }
  }
}

DI void phase_ret_norm(const Params& p) {
  const int tid = launder(threadIdx.x), lane = tid & 63, w = tid >> 6;
  for (int r = blockIdx.x * 8 + w; r < T_ * 4; r += gridDim.x * 8) {
    bf16_t* op = p.Or + (size_t)r * 512 + lane * 8;
    const bf16_t* gp = p.G + (size_t)r * 512 + lane * 8;
    u32x4 ov = *(const u32x4*)op, gv = *(const u32x4*)gp;
    float o[8], g[8];
#pragma unroll
    for (int i = 0; i < 4; ++i) { o[2 * i] = __uint_as_float(ov[i] << 16); o[2 * i + 1] = __uint_as_float(ov[i] & 0xffff0000u); g[2 * i] = __uint_as_float(gv[i] << 16); g[2 * i + 1] = __uint_as_float(gv[i] & 0xffff0000u); }
    float s = 0.f;
#pragma unroll
    for (int i = 0; i < 8; ++i) s += o[i];
#pragma unroll
    for (int of = 32; of > 0; of >>= 1) s += __shfl_xor(s, of);
    const float mu = s * (1.f / 512.f);
    float q = 0.f;
#pragma unroll
    for (int i = 0; i < 8; ++i) { float d = o[i] - mu; q += d * d; }
#pragma unroll
    for (int of = 32; of > 0; of >>= 1) q += __shfl_xor(q, of);
    const float rs = rsqrtf(q * (1.f / 512.f) + LN_EPS);
    u32x4 res;
#pragma unroll
    for (int i = 0; i < 4; ++i) {
      float a = (o[2 * i] - mu) * rs * (g[2 * i] / (1.f + __expf(-g[2 * i])));
      float b2 = (o[2 * i + 1] - mu) * rs * (g[2 * i + 1] / (1.f + __expf(-g[2 * i + 1])));
      res[i] = pack2(a, b2);
    }
    *(u32x4*)op = res;
  }
}

DI void phase_pool(const Params& p) {
  const size_t gtid = (size_t)blockIdx.x * NT + launder(threadIdx.x), gsz = (size_t)gridDim.x * NT;
  for (size_t i = gtid; i < (size_t)T_ * 256; i += gsz) {
    const int t = (int)(i >> 8), c4 = (int)(i & 255);
    const int wdw = 2 << (c4 >> 6);
    const int s = t & (S_ - 1);
    const int n = (s + 1) < wdw ? (s + 1) : wdw;
    const f32x4 x0 = ((const f32x4*)p.X)[i];
    f32x4 sum = x0;
    for (int u = 1; u < n; ++u) sum += ((const f32x4*)p.X)[i - (size_t)u * 256];
    const float rn = 1.f / (float)n;
    f32x4 r = sum * rn - x0;
    u32x2 o; o.x = pack2(r[0], r[1]); o.y = pack2(r[2], r[3]);
    ((u32x2*)p.Oa)[i] = o;
  }
}


#define XB_TMO      128
#define XB_XCNT(j)  (256  + 64 * (j))
#define XB_XSUB(j)  (1280 + 64 * (j))
#define XB_XGEN(j)  (2304 + 64 * (j))
#define XB_TOP      3328
#define XB_TOPGEN   3392
#define XCD_BAR_WORDS 3456
#define XB_SPIN_CAP (1u << 20)
#define LAS __attribute__((address_space(3)))
DI unsigned xb_ld(unsigned* p)              { return __hip_atomic_load(p, __ATOMIC_RELAXED, __HIP_MEMORY_SCOPE_AGENT); }
DI unsigned xb_add(unsigned* p, unsigned v) { return __hip_atomic_fetch_add(p, v, __ATOMIC_RELAXED, __HIP_MEMORY_SCOPE_AGENT); }
DI unsigned xb_xcc_id() { return (unsigned)__builtin_amdgcn_s_getreg((3 << 11) | 20) & 0xFu; }
#define XB_SPIN(cond, bar) do { unsigned _sp = 0; while (cond) { __builtin_amdgcn_s_sleep(1); \
    if ((++_sp & 255u) == 0u) { if (xb_ld(&(bar)[XB_TMO])) break; if (_sp > XB_SPIN_CAP) { atomicAdd(&(bar)[XB_TMO], 1u); break; } } } } while (0)
struct XcdBarrier { unsigned* bar; unsigned x; volatile LAS unsigned* st; };
DI XcdBarrier xcd_barrier_post(unsigned* bar, volatile LAS unsigned* st) {
  XcdBarrier b; b.bar = bar; b.x = xb_xcc_id(); b.st = st;
  if (threadIdx.x == 0) (void)xb_add(&bar[XB_XCNT(b.x)], 1u);
  return b;
}
DI void xcd_barrier_complete(unsigned* bar, unsigned x, unsigned& nloc, unsigned& nx) {
  const unsigned G = gridDim.x * gridDim.y * gridDim.z;
  unsigned sum, cnt, mine, sp = 0u;
  for (;;) {
    sum = 0u; cnt = 0u; mine = 0u;
#pragma unroll
    for (unsigned j = 0; j < 16; ++j) { const unsigned c = xb_ld(&bar[XB_XCNT(j)]); sum += c; cnt += (c > 0u) ? 1u : 0u; mine = (j == x) ? c : mine; }
    if (sum == G) break;
    __builtin_amdgcn_s_sleep(1);
    if ((++sp & 255u) == 0u) { if (xb_ld(&bar[XB_TMO])) break; if (sp > XB_SPIN_CAP) { atomicAdd(&bar[XB_TMO], 1u); break; } }
  }
  nloc = mine > 0u ? mine : 1u; nx = cnt > 0u ? cnt : 1u;
}
DI void xcd_barrier(const XcdBarrier& b) {
  asm volatile("s_waitcnt vmcnt(0)" ::: "memory");
  __syncthreads();
  if (threadIdx.x == 0) {
    unsigned* bar = b.bar;
    __builtin_amdgcn_s_waitcnt(0);
    unsigned nloc = b.st[0], nx = b.st[1];
    if (nloc == 0u) { xcd_barrier_complete(bar, b.x, nloc, nx); b.st[0] = nloc; b.st[1] = nx; }
    const unsigned old = xb_add(&bar[XB_XSUB(b.x)], 1u);
    const unsigned gen = old / nloc;
    if (old + 1u == (gen + 1u) * nloc) {
      __builtin_amdgcn_fence(__ATOMIC_RELEASE, "agent");
      asm volatile("s_waitcnt vmcnt(0)" ::: "memory");
      const unsigned og = xb_add(&bar[XB_TOP], 1u);
      const unsigned tg = og / nx;
      if (og + 1u == (tg + 1u) * nx) xb_add(&bar[XB_TOPGEN], 1u);
      else XB_SPIN(xb_ld(&bar[XB_TOPGEN]) == tg, bar);
      __builtin_amdgcn_fence(__ATOMIC_ACQUIRE, "agent");
      xb_add(&bar[XB_XGEN(b.x)], 1u);
      asm volatile("s_waitcnt vmcnt(0)" ::: "memory");
    } else {
      XB_SPIN(xb_ld(&bar[XB_XGEN(b.x)]) == gen, bar);
      __builtin_amdgcn_fence(__ATOMIC_ACQUIRE, "agent");
      asm volatile("s_waitcnt vmcnt(0)" ::: "memory");
    }
  }
  __syncthreads();
}

__global__ void __launch_bounds__(NT) fwd_megakernel(Params p) {
  __shared__ __attribute__((aligned(16))) char lds[LDS_BYTES];
  cg::grid_group grid = cg::this_grid();
  __shared__ uint4 xb_words;
  if (threadIdx.x == 0) xb_words = make_uint4(0u, 0u, 0u, 0u);
  __syncthreads();
  const XcdBarrier xb = xcd_barrier_post(p.bar, (volatile LAS unsigned*)&xb_words);
  if (threadIdx.x == 0) { const unsigned r = xb_add(&p.xrank[xb.x * 64], 1u); __hip_atomic_store(&p.xrank[(8 + blockIdx.x) * 64], r * 8u + xb.x, __ATOMIC_RELAXED, __HIP_MEMORY_SCOPE_AGENT); }

  for (int rep_ = 0; rep_ < ((PROBE_DUP & 32) ? 2 : 1); ++rep_) { phase_prologue(p, lds); }
  if (p.njobs < 0) grid.sync();
  xcd_barrier(xb);
  int vb = blockIdx.x;
  {
    bool even = gridDim.x == 256;
#pragma unroll
    for (int q = 0; q < 8; ++q) even = even && (xb_ld(&p.xrank[q * 64]) == 32u);
    if (even) vb = (int)(xb_ld(&p.xrank[(8 + blockIdx.x) * 64]));
  }
  for (int st = -1; st < 16; ++st) {
    const int i = st >> 2, k = st & 3;
    const int mx = i % 3, j = i / 3;
    const int nsp = st < 0 ? 1 : (k == 0 || k == 3) ? 2 : k == 2 ? 3 : (mx == 0 ? 3 : mx == 1 ? 2 : 4);
    for (int sp = 0; sp < nsp; ++sp) {
      if (st < 0) {
        for (int t = blockIdx.x; t < 256; t += gridDim.x) {
          int layer = t >> 6, pm = t & 7, pn = (t >> 3) & 7;
          EpiXkv e{p.Kx + (size_t)layer * 2048 * D_, p.Vxt + (size_t)layer * 32 * 256 * 256};
          gemm_tile<4, 64>(p.memb, D_, p.wxkv[layer], D_, D_, pm * 256, pn * 256, lds, e);
        }
      } else if (k == 0 || k == 3) {
        const int f = k == 3 ? 1 : 0;
        if (sp == 0) {
          EpiSwiglu e1{p.H};
          for (int rep_ = 0; rep_ < ((PROBE_DUP & 1) ? 2 : 1); ++rep_) {
            gemm_phase256(p.Xb, D_, p.win[i * 2 + f], D_, 20, lds, e1, vb);
            for (int t = vb; t < 256; t += gridDim.x) {
              const int x = t & 7, L = t >> 3; const int pm = 8 * x + (L & 7), pnh = L >> 3;
              gemm_tile<4, 64, EpiSwiglu, 2>(p.Xb, D_, p.win[i * 2 + f], D_, D_, pm * 256, 5120 + pnh * 128, lds, e1);
            }
          }
        } else {
          const int lnidx = i * 4 + (f ? 3 : 0);
          EpiLNX e2{(st == 0) ? p.x : (const float*)p.X, (st == 15) ? p.out : p.X, p.Xb, nullptr, nullptr, p.ln_g + lnidx * D_, p.ln_b + lnidx * D_, 0.5f, p.xstat, p.xcnt, p.bar + XB_TMO, 4u * (unsigned)(lnidx + 1)};
          gemm_phaseLNX(p.H, F_, p.wout[i * 2 + f], lds, e2, vb);
        }
      } else if (k == 1) {
        const int lnidx = i * 4 + 1;
        const bool last = sp == nsp - 1;
        if (last) {
          const bf16_t* A = mx == 2 ? p.Or : p.Oa;
          const int K = mx == 2 ? 2048 : D_;
          const bf16_t* W = mx == 0 ? p.wdo[j] : mx == 1 ? p.wpool : p.wreto;
          EpiLNX e2{p.X, p.X, p.Xb, mx == 1 ? p.pool_b : nullptr, mx == 1 ? p.pool_scale : nullptr, p.ln_g + lnidx * D_, p.ln_b + lnidx * D_, 1.f, p.xstat, p.xcnt, p.bar + XB_TMO, 4u * (unsigned)(lnidx + 1)};
          gemm_phaseLNX(A, K, W, lds, e2, vb, mx == 1);
        } else if (mx == 0) {
          if (sp == 0) { EpiDAqkv e1{p.Q, p.Kb, p.Vt, p.cosD, p.sinD}; gemm_phase256(p.Xb, D_, p.wqkv[j], D_, 12, lds, e1, vb); }
          else for (int rep_ = 0; rep_ < ((PROBE_DUP & 4) ? 2 : 1); ++rep_) { phase_da_attn(p, j, lds); }
        } else if (mx == 1) {
          phase_pool(p);
        } else {
          if (sp == 0) { EpiRETqkvg e1{p.Q, p.Kb, p.Vt, p.Vrt, p.G, p.cosR, p.sinR}; gemm_phase256(p.Xb, D_, p.wret, D_, 24, lds, e1, vb); }
          else if (sp == 1) for (int rep_ = 0; rep_ < ((PROBE_DUP & 8) ? 2 : 1); ++rep_) { phase_ret(p, lds); }
          else phase_ret_norm(p);
        }
      } else {
        const int lnidx = i * 4 + 2;
        if (sp == 0) { EpiPlain e1{p.Q, 0.0625f}; gemm_phase256(p.Xb, D_, p.wxq[i], D_, 4, lds, e1, vb); }
        else if (sp == 1) for (int rep_ = 0; rep_ < ((PROBE_DUP & 16) ? 2 : 1); ++rep_) { phase_xa_attn(p, i, lds); }
        else { EpiLNX e2{p.X, p.X, p.Xb, nullptr, nullptr, p.ln_g + lnidx * D_, p.ln_b + lnidx * D_, 1.f, p.xstat, p.xcnt, p.bar + XB_TMO, 4u * (unsigned)(lnidx + 1)}; gemm_phaseLNX(p.Oa, D_, p.wxo[i], lds, e2, vb); }
      }
      if (!(st == 15 && sp == nsp - 1)) xcd_barrier(xb);
    }
  }
}

extern "C" void kernel_launch(void* const* d_in, const int* in_sizes, int n_in, void* d_out, int out_size, void* d_ws, size_t ws_size, hipStream_t stream) {
  (void)in_sizes; (void)n_in; (void)out_size;
  static Params p;
  static int grid_blocks = 0;
  static bool ok = true;
  if (!grid_blocks) {
    int dev = 0, cus = 0, per_cu = 0;
    hipGetDevice(&dev);
    hipDeviceGetAttribute(&cus, hipDeviceAttributeMultiprocessorCount, dev);
    hipOccupancyMaxActiveBlocksPerMultiprocessor(&per_cu, fwd_megakernel, NT, 0);
    if (per_cu < 1) per_cu = 1;
    grid_blocks = 256;
    if (cus < 256) { fprintf(stderr, "needs 256 CUs, device has %d\n", cus); ok = false; }
  }
  std::memset((void*)&p, 0, sizeof(p));
  const float* x = (const float*)d_in[0]; const float* mem = (const float*)d_in[1]; const int* pos = (const int*)d_in[2];
  const float* ffn_w_in = (const float*)d_in[3]; const float* ffn_w_out = (const float*)d_in[4];
  const float* ln_g = (const float*)d_in[5]; const float* ln_b = (const float*)d_in[6];
  const float* da_w_qkv = (const float*)d_in[7]; const float* da_w_o = (const float*)d_in[8];
  const float* da_lam_q = (const float*)d_in[9]; const float* da_lam_k = (const float*)d_in[10]; const float* da_subln_g = (const float*)d_in[11];
  const float* pool_w = (const float*)d_in[12]; const float* pool_b = (const float*)d_in[13]; const float* pool_scale = (const float*)d_in[14];
  const float* ret_w_qkvg = (const float*)d_in[15]; const float* ret_w_o = (const float*)d_in[16];
  const float* xa_wq = (const float*)d_in[17]; const float* xa_wkv = (const float*)d_in[18]; const float* xa_wo = (const float*)d_in[19];
  p.x = x; p.mem = mem; p.pos = pos; p.ln_g = ln_g; p.ln_b = ln_b; p.lam_q = da_lam_q; p.lam_k = da_lam_k; p.subln_g = da_subln_g; p.pool_b = pool_b; p.pool_scale = pool_scale;
  p.out = (float*)d_out;
  char* ws = (char*)d_ws; size_t off = 0;
  auto alloc = [&](size_t bytes) { char* r = ws + off; off += (bytes + 255) & ~(size_t)255; return r; };
  const size_t U = (size_t)T_ * 1024 * 2;
  p.bar = (unsigned*)alloc(XCD_BAR_WORDS * 4 + 64 * 256 + 264 * 256);
  p.xcnt = p.bar + XCD_BAR_WORDS;
  p.xrank = p.xcnt + 64 * 64;
  p.xstat = (u64_t*)alloc((size_t)64 * 256 * 4 * 8);
  p.X = (float*)alloc((size_t)T_ * D_ * 4); p.Xb = (bf16_t*)alloc(U); p.memb = (bf16_t*)alloc((size_t)2048 * D_ * 2);
  p.cosD = (float*)alloc((size_t)T_ * 32 * 4); p.sinD = (float*)alloc((size_t)T_ * 32 * 4);
  p.cosR = (float*)alloc((size_t)T_ * 128 * 4); p.sinR = (float*)alloc((size_t)T_ * 128 * 4);
  p.Kx = (bf16_t*)alloc((size_t)4 * 2048 * D_ * 2); p.Vxt = (bf16_t*)alloc((size_t)4 * 2048 * D_ * 2);
  char* big = alloc(10 * U);
  p.H = (bf16_t*)big; p.Q = (bf16_t*)big; p.Kb = (bf16_t*)(big + U); p.Vt = (bf16_t*)(big + 2 * U); p.Oa = (bf16_t*)(big + 3 * U);
  p.Vrt = (bf16_t*)(big + 4 * U); p.G = (bf16_t*)(big + 6 * U); p.Or = (bf16_t*)(big + 8 * U);
  int nj = 0; int tiles = 0;
  auto job = [&](const float* src, int K, int N, int lds_, int perm) {
    bf16_t* dst = (bf16_t*)alloc((size_t)K * N * 2);
    TJob& j = p.jobs[nj]; j.src = src; j.dst = dst; j.K = K; j.N = N; j.lds_ = lds_; j.ldd = K; j.perm = perm; j.pad = 0;
    p.tile_start[nj] = tiles; tiles += (K / 128) * (N / 128); ++nj; return (const bf16_t*)dst;
  };
  for (int i = 0; i < 8; ++i) {
    p.win[i] = job(ffn_w_in + (size_t)i * D_ * 2 * F_, D_, 2 * F_, 2 * F_, 1);
    p.wout[i] = job(ffn_w_out + (size_t)i * F_ * D_, F_, D_, D_, 0);
  }
  for (int j = 0; j < 2; ++j) {
    p.wqkv[j] = job(da_w_qkv + (size_t)j * D_ * 3072, D_, 3072, 3072, 0);
    p.wdo[j] = job(da_w_o + (size_t)j * D_ * D_, D_, D_, D_, 0);
  }
  p.wret = job(ret_w_qkvg, D_, 6144, 6144, 3);
  p.wreto = job(ret_w_o, 2048, D_, D_, 0);
  for (int i = 0; i < 4; ++i) {
    p.wxq[i] = job(xa_wq + (size_t)i * D_ * D_, D_, D_, D_, 0);
    p.wxkv[i] = job(xa_wkv + (size_t)i * D_ * 2048, D_, 2048, 2048, 0);
    p.wxo[i] = job(xa_wo + (size_t)i * D_ * D_, D_, D_, D_, 0);
  }
  p.wpool = job(pool_w, D_, D_, 256, 4);
  p.njobs = nj; p.tile_start[nj] = tiles;
  p.lam_init[0] = (float)(0.8 - 0.6 * exp(-0.3 * 0.0));
  p.lam_init[1] = (float)(0.8 - 0.6 * exp(-0.3 * 3.0));
  if (!ok) return;
  if (off > ws_size || nj != NJOBS) { if (ok) fprintf(stderr, "workspace too small or job count mismatch: need %zu have %zu, jobs %d\n", off, ws_size, nj); ok = false; return; }
  hipMemsetAsync(p.bar, 0, XCD_BAR_WORDS * 4 + 64 * 256 + 264 * 256, stream);
  void* args[] = {&p};
  hipError_t e = hipLaunchCooperativeKernel((void*)fwd_megakernel, dim3(grid_blocks), dim3(NT), args, 0, stream);
  if (e != hipSuccess) fprintf(stderr, "cooperative launch failed: %s (grid %d)\n", hipGetErrorString(e), grid_blocks);
}
```

```cpp
#include <hip/hip_runtime.h>
#include <hip/hip_cooperative_groups.h>
#include <cstdio>
#include <cstdint>
#include <cmath>
#include <cstring>
namespace cg = cooperative_groups;

#define DI __device__ __forceinline__
typedef unsigned short bf16_t;
typedef short bf16x8 __attribute__((ext_vector_type(8)));
typedef short s16x4 __attribute__((ext_vector_type(4)));
typedef float f32x16 __attribute__((ext_vector_type(16)));
typedef float f32x4 __attribute__((ext_vector_type(4)));
typedef float f32x2 __attribute__((ext_vector_type(2)));
typedef unsigned u32x4 __attribute__((ext_vector_type(4)));
typedef unsigned u32x2 __attribute__((ext_vector_type(2)));
typedef __bf16 bf2_t __attribute__((ext_vector_type(2)));

#ifndef PROBE_DUP
#define PROBE_DUP 0
#endif
constexpr int NT = 512;
constexpr int T_ = 16384, D_ = 1024, S_ = 2048, F_ = 2816;
constexpr int LDS_BYTES = 139264;
constexpr float LN_EPS = 1e-5f;
constexpr float ALPHA = 1.681792830507429f;
constexpr float LOG2E = 1.4426950408889634f;

DI unsigned pack2(float lo, float hi) { f32x2 v = {lo, hi}; bf2_t r = __builtin_convertvector(v, bf2_t); return __builtin_bit_cast(unsigned, r); }
DI bf16_t f2bf(float x) { return (bf16_t)(pack2(x, 0.f) & 0xffffu); }
DI float bf2f(bf16_t v) { return __uint_as_float(((unsigned)v) << 16); }
DI int crow(int i, int hh) { return (i & 3) + 8 * (i >> 2) + 4 * hh; }
DI f32x16 mfma(bf16x8 a, bf16x8 b, f32x16 c) { return __builtin_amdgcn_mfma_f32_32x32x16_bf16(a, b, c, 0, 0, 0); }
DI f32x16 zero16() { f32x16 z; for (int i = 0; i < 16; ++i) z[i] = 0.f; return z; }
DI float ex2(float x) { return __builtin_amdgcn_exp2f(x); }
DI int launder(int x) { asm volatile("" : "+v"(x)); return x; }


typedef unsigned long long u64_t;
DI unsigned ag_ld32(unsigned* p) { return __hip_atomic_load(p, __ATOMIC_RELAXED, __HIP_MEMORY_SCOPE_AGENT); }
DI unsigned ag_add32(unsigned* p, unsigned v) { return __hip_atomic_fetch_add(p, v, __ATOMIC_RELAXED, __HIP_MEMORY_SCOPE_AGENT); }
DI u64_t ag_ld64(u64_t* p) { return __hip_atomic_load(p, __ATOMIC_RELAXED, __HIP_MEMORY_SCOPE_AGENT); }
DI void ag_st64(u64_t* p, u64_t v) { __hip_atomic_store(p, v, __ATOMIC_RELAXED, __HIP_MEMORY_SCOPE_AGENT); }


template <int CTRL> DI float dpp_f(float v) { return __int_as_float(__builtin_amdgcn_update_dpp(0, __float_as_int(v), CTRL, 0xF, 0xF, true)); }
DI float row16_sum(float v) {
  v += dpp_f<0xB1>(v);
  v += dpp_f<0x4E>(v);
  v += dpp_f<0x141>(v);
  v += dpp_f<0x140>(v);
  return v;
}


DI float xhalf_max(float v) { auto r = __builtin_amdgcn_permlane32_swap(__float_as_uint(v), __float_as_uint(v), false, false); return fmaxf(__uint_as_float(r[0]), __uint_as_float(r[1])); }
DI float xhalf_sum(float v) { auto r = __builtin_amdgcn_permlane32_swap(__float_as_uint(v), __float_as_uint(v), false, false); return __uint_as_float(r[0]) + __uint_as_float(r[1]); }

struct TJob { const float* src; bf16_t* dst; int K, N, lds_, ldd, perm, pad; };
constexpr int NJOBS = 35;

struct Params {
  const float *x, *mem; const int* pos;
  const float *ln_g, *ln_b, *lam_q, *lam_k, *subln_g, *pool_b, *pool_scale;
  float* out; unsigned* bar; unsigned* xcnt; unsigned* xrank; u64_t* xstat;
  float* X; bf16_t* Xb; bf16_t* memb;
  float *cosD, *sinD, *cosR, *sinR;
  bf16_t *Kx, *Vxt;
  bf16_t *H, *Q, *Kb, *Vt, *Oa, *Vrt, *G, *Or;
  const bf16_t *win[8], *wout[8], *wqkv[2], *wdo[2], *wpool, *wret, *wreto, *wxq[4], *wxkv[4], *wxo[4];
  float lam_init[2];
  int njobs; int pad;
  int tile_start[NJOBS + 1];
  TJob jobs[NJOBS];
};

template <int BK> DI int swz(int row) { constexpr int CPR = BK / 8; return (row / (16 / CPR)) % CPR; }

template <int ROWS, int BK>
DI void stage_tile(const bf16_t* g, int ld, char* l, int tid) {
  constexpr int CPR = BK / 8, TOT = ROWS * CPR, N = (TOT + NT - 1) / NT;
  const int row0 = tid / CPR, pc = tid % CPR; const int c = pc ^ swz<BK>(row0);
  const unsigned voff = (unsigned)(row0 * ld + c * 8) * 2u;
#pragma unroll
  for (int i = 0; i < N; ++i) {
    if (TOT % NT == 0 || tid + i * NT < TOT) {
      const char* gb = (const char*)g + (size_t)i * (NT / CPR) * ld * 2;
      __builtin_amdgcn_global_load_lds((const unsigned*)(gb + voff), (__attribute__((address_space(3))) unsigned*)(l + i * NT * 16 + __builtin_amdgcn_readfirstlane(tid >> 6) * 1024), 16, 0, 0);
    }
  }
}
DI void wait_vm0() { asm volatile("s_waitcnt vmcnt(0)" ::: "memory"); }

template <int ROWS, int BK>
DI void stage_piece(const bf16_t* g, int ld, char* l, int tid, int i, int wv) {
  constexpr int CPR = BK / 8, TOT = ROWS * CPR;
  const int row0 = tid / CPR, pc = tid % CPR; const int c = pc ^ swz<BK>(row0);
  const unsigned voff = (unsigned)(row0 * ld + c * 8) * 2u;
  if (TOT % NT == 0 || tid + i * NT < TOT) {
    const char* gb = (const char*)g + (size_t)i * (NT / CPR) * ld * 2;
    __builtin_amdgcn_global_load_lds((const unsigned*)(gb + voff), (__attribute__((address_space(3))) unsigned*)(l + i * NT * 16 + wv * 1024), 16, 0, 0);
  }
}

template <int WM, int BK, class Epi, int NTW = 4>
DI void gemm_tile(const bf16_t* __restrict__ A, int lda, const bf16_t* __restrict__ Bt, int ldb, int K, int row0, int col0, char* lds, Epi& epi,
                  bool pre = false, bool has_next = false, int row0n = 0, int col0n = 0) {
  constexpr int WN = 8 / WM, BM = 64 * WM, BN = 32 * NTW * WN, ABYTES = BM * BK * 2, STG = (BM + BN) * BK * 2;
  constexpr int NKK = BK / 16;
  constexpr int NPA = (BM * (BK / 8) + NT - 1) / NT, NPB = (BN * (BK / 8) + NT - 1) / NT, NP = NPA + NPB, PPK = (NP + NKK - 1) / NKK;
  static_assert(2 * STG <= LDS_BYTES, "lds");
  const int tid = launder(threadIdx.x), lane = tid & 63, w = tid >> 6, wm = w % WM, wn = w / WM;
  const int l31 = lane & 31, hh = lane >> 5;
  f32x16 acc[2][NTW];
#pragma unroll
  for (int a = 0; a < 2; ++a)
#pragma unroll
    for (int b = 0; b < NTW; ++b) acc[a][b] = zero16();
  const bf16_t* Ag = A + (size_t)row0 * lda; const bf16_t* Bg = Bt + (size_t)col0 * ldb;
  const int wv = __builtin_amdgcn_readfirstlane(tid >> 6);
  __syncthreads();
  if (!pre) { stage_tile<BM, BK>(Ag, lda, lds, tid); stage_tile<BN, BK>(Bg, ldb, lds + ABYTES, tid); }
  wait_vm0();
  __syncthreads();
  const int nk = K / BK;
  for (int kt = 0; kt < nk; ++kt) {
    char* cur = lds + (kt & 1) * STG; char* nxt = lds + ((kt + 1) & 1) * STG;
    const bool more = kt + 1 < nk;
    const bf16_t* An = Ag + (kt + 1) * BK; const bf16_t* Bn = Bg + (kt + 1) * BK;
    if (!more) epi.pre(row0 + wm * 64, col0 + wn * (32 * NTW), lane, w, lds);
    bf16x8 fa[2][2], fb[2][NTW];
#pragma unroll
    for (int mt = 0; mt < 2; ++mt) { int row = wm * 64 + mt * 32 + l31; fa[0][mt] = *(const bf16x8*)(cur + row * (BK * 2) + ((hh ^ swz<BK>(row)) << 4)); }
#pragma unroll
    for (int nt = 0; nt < NTW; ++nt) { int row = wn * (32 * NTW) + nt * 32 + l31; fb[0][nt] = *(const bf16x8*)(cur + ABYTES + row * (BK * 2) + ((hh ^ swz<BK>(row)) << 4)); }
#pragma unroll
    for (int kk = 0; kk < NKK; ++kk) {
      if (kk + 1 < NKK) {
        const int ch = (kk + 1) * 2 + hh;
#pragma unroll
        for (int mt = 0; mt < 2; ++mt) { int row = wm * 64 + mt * 32 + l31; fa[(kk + 1) & 1][mt] = *(const bf16x8*)(cur + row * (BK * 2) + ((ch ^ swz<BK>(row)) << 4)); }
#pragma unroll
        for (int nt = 0; nt < NTW; ++nt) { int row = wn * (32 * NTW) + nt * 32 + l31; fb[(kk + 1) & 1][nt] = *(const bf16x8*)(cur + ABYTES + row * (BK * 2) + ((ch ^ swz<BK>(row)) << 4)); }
      }
      if (more) {
#pragma unroll
        for (int q = 0; q < PPK; ++q) {
          const int pi = kk * PPK + q;
          if (pi < NPA) stage_piece<BM, BK>(An, lda, nxt, tid, pi, wv);
          else if (pi < NP) stage_piece<BN, BK>(Bn, ldb, nxt + ABYTES, tid, pi - NPA, wv);
        }
      }
      __builtin_amdgcn_s_setprio(1);
#pragma unroll
      for (int mt = 0; mt < 2; ++mt)
#pragma unroll
        for (int nt = 0; nt < NTW; ++nt) acc[mt][nt] = mfma(fa[kk & 1][mt], fb[kk & 1][nt], acc[mt][nt]);
      __builtin_amdgcn_s_setprio(0);
      __builtin_amdgcn_sched_barrier(0);
    }
    wait_vm0();
    __syncthreads();
  }
  if (has_next) { const int tid3 = launder(threadIdx.x); stage_tile<BM, BK>(A + (size_t)row0n * lda, lda, lds, tid3); stage_tile<BN, BK>(Bt + (size_t)col0n * ldb, ldb, lds + ABYTES, tid3); }
  { const int tid2 = launder(threadIdx.x); epi(acc, row0 + (((tid2 >> 6) % WM) * 64), col0 + (((tid2 >> 6) / WM) * (32 * NTW)), tid2 & 63, tid2 >> 6, lds); }
}

template <class Epi>
DI void gemm_tile_p4(const bf16_t* __restrict__ A, int lda, const bf16_t* __restrict__ Bt, int ldb, int K, int row0, int col0, char* lds, Epi& epi) {
  constexpr int BK = 32, BM = 256, BN = 256, ABYTES = BM * BK * 2, STG = (BM + BN) * BK * 2, NS = 4;
  static_assert(NS * STG <= LDS_BYTES, "lds");
  const int tid = launder(threadIdx.x), lane = tid & 63, w = tid >> 6, wm = w & 3, wn = w >> 2;
  const int l31 = lane & 31, hh = lane >> 5;
  f32x16 acc[2][4];
#pragma unroll
  for (int a = 0; a < 2; ++a)
#pragma unroll
    for (int b = 0; b < 4; ++b) acc[a][b] = zero16();
  const bf16_t* Ag = A + (size_t)row0 * lda; const bf16_t* Bg = Bt + (size_t)col0 * ldb;
  const int nk = K / BK;
  __syncthreads();
#pragma unroll
  for (int s = 0; s < NS - 1; ++s) { stage_tile<BM, BK>(Ag + s * BK, lda, lds + s * STG, tid); stage_tile<BN, BK>(Bg + s * BK, ldb, lds + s * STG + ABYTES, tid); }
  int aoff[2][2], boff[4][2];
#pragma unroll
  for (int kk = 0; kk < 2; ++kk) {
    const int ch = kk * 2 + hh;
#pragma unroll
    for (int mt = 0; mt < 2; ++mt) { int row = wm * 64 + mt * 32 + l31; aoff[mt][kk] = row * (BK * 2) + ((ch ^ swz<BK>(row)) << 4); }
#pragma unroll
    for (int nt = 0; nt < 4; ++nt) { int row = wn * 128 + nt * 32 + l31; boff[nt][kk] = ABYTES + row * (BK * 2) + ((ch ^ swz<BK>(row)) << 4); }
  }
  for (int kt = 0; kt < nk; ++kt) {
    if (kt + 2 < nk) asm volatile("s_waitcnt vmcnt(8)" ::: "memory");
    else if (kt + 1 < nk) asm volatile("s_waitcnt vmcnt(4)" ::: "memory");
    else asm volatile("s_waitcnt vmcnt(0)" ::: "memory");
    __builtin_amdgcn_s_barrier();
    asm volatile("" ::: "memory");
    if (kt + NS - 1 < nk) { char* nxt = lds + ((kt + NS - 1) & (NS - 1)) * STG; stage_tile<BM, BK>(Ag + (kt + NS - 1) * BK, lda, nxt, tid); stage_tile<BN, BK>(Bg + (kt + NS - 1) * BK, ldb, nxt + ABYTES, tid); }
    const char* cur = lds + (kt & (NS - 1)) * STG;
#pragma unroll
    for (int kk = 0; kk < 2; ++kk) {
      bf16x8 a[2], b[4];
#pragma unroll
      for (int mt = 0; mt < 2; ++mt) a[mt] = *(const bf16x8*)(cur + aoff[mt][kk]);
#pragma unroll
      for (int nt = 0; nt < 4; ++nt) b[nt] = *(const bf16x8*)(cur + boff[nt][kk]);
#pragma unroll
      for (int mt = 0; mt < 2; ++mt)
#pragma unroll
        for (int nt = 0; nt < 4; ++nt) acc[mt][nt] = mfma(a[mt], b[nt], acc[mt][nt]);
    }
  }
  __syncthreads();
  { const int tid2 = launder(threadIdx.x); epi(acc, row0 + (((tid2 >> 6) & 3) * 64), col0 + (((tid2 >> 6) >> 2) * 128), tid2 & 63, tid2 >> 6, lds); }
}

struct EpiSwiglu {
  DI void pre(int, int, int, int, char*) {}
  bf16_t* H;
  template <int NTW>
  DI void operator()(f32x16 (&acc)[2][NTW], int grow0, int gcol0, int lane, int w, char* lds) {
    const int l31 = lane & 31, hh = lane >> 5;
#pragma unroll
    for (int mt = 0; mt < 2; ++mt)
#pragma unroll
      for (int pr = 0; pr < NTW / 2; ++pr) {
        const int col = (gcol0 / 64 + pr) * 32 + l31;
#pragma unroll
        for (int i = 0; i < 16; ++i) {
          float g = acc[mt][2 * pr][i], u = acc[mt][2 * pr + 1][i];
          float v = g * __builtin_amdgcn_rcpf(1.f + __expf(-g)) * u;
          int row = grow0 + mt * 32 + crow(i, hh);
          H[(size_t)row * F_ + col] = f2bf(v);
        }
      }
  }
};

struct EpiLN {
  DI void pre(int, int, int, int, char*) {}
  const float* Xin; float* Xout; bf16_t* Xb; const float* bias; const float* cscale; const float* g; const float* b; float hs;
  DI void operator()(f32x16 (&acc)[2][4], int grow0, int gcol0, int lane, int w, char* lds) {
    float* red = (float*)lds; float* stat = red + 8 * 64 * 2;
    const int l31 = lane & 31, hh = lane >> 5, tid = w * 64 + lane;
    float bia[4], csc[4];
#pragma unroll
    for (int nt = 0; nt < 4; ++nt) { int c = gcol0 + nt * 32 + l31; bia[nt] = bias ? bias[c] : 0.f; csc[nt] = cscale ? cscale[c] : 1.f; }
    const unsigned base1 = (unsigned)((grow0 + 4 * hh) * D_ + gcol0 + l31);
#pragma unroll
    for (int mt = 0; mt < 2; ++mt) {
#pragma unroll
      for (int i = 0; i < 16; ++i) {
        const unsigned off = base1 + (unsigned)((mt * 32 + (i & 3) + 8 * (i >> 2)) * D_);
        float s1 = 0.f, s2 = 0.f;
#pragma unroll
        for (int nt = 0; nt < 4; ++nt) {
          float v = (acc[mt][nt][i] + bia[nt]) * csc[nt];
          float z = ALPHA * Xin[off + nt * 32] + hs * v;
          acc[mt][nt][i] = z; s1 += z; s2 += z * z;
        }
#pragma unroll
        for (int o = 16; o > 0; o >>= 1) { s1 += __shfl_xor(s1, o); s2 += __shfl_xor(s2, o); }
        if (l31 == 0) { int lr = mt * 32 + crow(i, hh); f32x2 sv = {s1, s2}; *(f32x2*)(red + (w * 64 + lr) * 2) = sv; }
        asm volatile("" ::: "memory");
      }
    }
    __syncthreads();
    if (tid < 64) {
      float s1 = 0.f, s2 = 0.f;
#pragma unroll
      for (int ww = 0; ww < 8; ++ww) { s1 += red[(ww * 64 + tid) * 2]; s2 += red[(ww * 64 + tid) * 2 + 1]; }
      float mean = s1 * (1.f / 1024.f); float var = s2 * (1.f / 1024.f) - mean * mean; var = var < 0.f ? 0.f : var;
      stat[tid * 2] = mean; stat[tid * 2 + 1] = rsqrtf(var + LN_EPS);
    }
    __syncthreads();
    const int lane2 = launder(lane); const int l31b = lane2 & 31, hhb = lane2 >> 5;
    float gg[4], bb[4];
#pragma unroll
    for (int nt = 0; nt < 4; ++nt) { int c = gcol0 + nt * 32 + l31b; gg[nt] = g[c]; bb[nt] = b[c]; }
    const unsigned base2 = (unsigned)((grow0 + 4 * hhb) * D_ + gcol0 + l31b);
#pragma unroll
    for (int mt = 0; mt < 2; ++mt)
#pragma unroll
      for (int i = 0; i < 16; ++i) {
        const int lr = mt * 32 + (i & 3) + 8 * (i >> 2) + 4 * hhb;
        const unsigned off = base2 + (unsigned)((mt * 32 + (i & 3) + 8 * (i >> 2)) * D_);
        const f32x2 st2 = *(const f32x2*)(stat + lr * 2);
#pragma unroll
        for (int nt = 0; nt < 4; ++nt) {
          float v = (acc[mt][nt][i] - st2.x) * st2.y * gg[nt] + bb[nt];
          Xout[off + nt * 32] = v; Xb[off + nt * 32] = f2bf(v);
        }
        asm volatile("" ::: "memory");
      }
  }
};

struct EpiLNX {
  const float* Xin; float* Xout; bf16_t* Xb; const float* bias; const float* cscale; const float* g; const float* b; float hs;
  u64_t* xstat; unsigned* xcnt; unsigned* tmo; unsigned target;
  DI void xpass(int ps, int grow0, int gcol0, int lane, int w, char* lds) const {
    char* xs = lds + (ps & 1) * 65536 + __builtin_amdgcn_readfirstlane(w) * 8192;
    const float* xsrc = Xin + (size_t)(grow0 + (ps >> 1) * 32 + (ps & 1) * 16 + (lane >> 5)) * D_ + gcol0 + (lane & 31) * 4;
#pragma unroll
    for (int pc = 0; pc < 8; ++pc)
      __builtin_amdgcn_global_load_lds((const unsigned*)(xsrc + (size_t)(2 * pc) * D_), (__attribute__((address_space(3))) unsigned*)(xs + pc * 1024), 16, 0, 0);
  }
  DI void pre(int grow0, int gcol0, int lane, int w, char* lds) { xpass(0, grow0, gcol0, lane, w, lds); }
  DI void operator()(f32x16 (&acc)[2][4], int grow0, int gcol0, int lane, int w, char* lds) {
    float* red = (float*)(lds + 131072); float* stat = (float*)lds;
    const int l31 = lane & 31, hh = lane >> 5, tid = w * 64 + lane;
    const int pm = grow0 >> 8, pn = gcol0 >> 8, wn = (gcol0 >> 7) & 1, lrow0 = grow0 & 255;
    float bia[4], csc[4];
#pragma unroll
    for (int nt = 0; nt < 4; ++nt) { int c = gcol0 + nt * 32 + l31; bia[nt] = bias ? bias[c] : 0.f; csc[nt] = cscale ? cscale[c] : 1.f; }
    float* redw = red + ((wn * 2 + ((lane >> 4) & 1)) * 256 + lrow0 + 4 * hh) * 2;
#pragma unroll
    for (int ps = 0; ps < 4; ++ps) {
      const int mt = ps >> 1;
      if (ps + 1 < 4) {
        if (ps >= 1) asm volatile("s_waitcnt lgkmcnt(0)" ::: "memory");
        xpass(ps + 1, grow0, gcol0, lane, w, lds);
        if (ps >= 1) asm volatile("s_waitcnt vmcnt(8)" ::: "memory");
      } else asm volatile("s_waitcnt vmcnt(0)" ::: "memory");
      const char* xs = lds + (ps & 1) * 65536 + w * 8192;
#pragma unroll
      for (int qq = 0; qq < 2; ++qq)
#pragma unroll
        for (int e = 0; e < 4; ++e) {
          const int i = 4 * (2 * (ps & 1) + qq) + e;
          const float* xr = (const float*)(xs + (8 * qq + 4 * hh + e) * 512) + l31;
          float s1 = 0.f, s2 = 0.f;
#pragma unroll
          for (int nt = 0; nt < 4; ++nt) {
            float v = (acc[mt][nt][i] + bia[nt]) * csc[nt];
            float z = ALPHA * xr[nt * 32] + hs * v;
            acc[mt][nt][i] = z; s1 += z; s2 += z * z;
          }
          s1 = row16_sum(s1); s2 = row16_sum(s2);
          if ((lane & 15) == 0) { f32x2 sv = {s1, s2}; *(f32x2*)(redw + (mt * 32 + (i & 3) + 8 * (i >> 2)) * 2) = sv; }
        }
    }
    __syncthreads();
    u64_t* myslots = xstat + ((size_t)pm * 256) * 4;
    if (tid < 256) {
      float s1 = (red[tid * 2] + red[(256 + tid) * 2]) + (red[(512 + tid) * 2] + red[(768 + tid) * 2]);
      float s2 = (red[tid * 2 + 1] + red[(256 + tid) * 2 + 1]) + (red[(512 + tid) * 2 + 1] + red[(768 + tid) * 2 + 1]);
      ag_st64(myslots + tid * 4 + pn, ((u64_t)__float_as_uint(s2) << 32) | (u64_t)__float_as_uint(s1));
    }
    asm volatile("s_waitcnt vmcnt(0)" ::: "memory");
    __syncthreads();
    if (tid == 0) {
      unsigned* c = xcnt + pm * 64;
      ag_add32(c, 1u);
      unsigned sp = 0;
      while (ag_ld32(c) < target) {
        __builtin_amdgcn_s_sleep(1);
        if ((++sp & 255u) == 0u) { if (ag_ld32(tmo)) break; if (sp > (1u << 20)) { atomicAdd(tmo, 1u); break; } }
      }
    }
    __syncthreads();
    if (tid < 256) {
      float s1 = 0.f, s2 = 0.f;
#pragma unroll
      for (int q = 0; q < 4; ++q) { u64_t v = ag_ld64(myslots + tid * 4 + q); s1 += __uint_as_float((unsigned)v); s2 += __uint_as_float((unsigned)(v >> 32)); }
      float mean = s1 * (1.f / 1024.f); float var = s2 * (1.f / 1024.f) - mean * mean; var = var < 0.f ? 0.f : var;
      f32x2 sv = {mean, rsqrtf(var + LN_EPS)}; *(f32x2*)(stat + tid * 2) = sv;
    }
    __syncthreads();
    const int lane2 = launder(lane); const int l31b = lane2 & 31, hhb = lane2 >> 5;
    float gg[4], bb[4];
#pragma unroll
    for (int nt = 0; nt < 4; ++nt) { int c = gcol0 + nt * 32 + l31b; gg[nt] = g[c]; bb[nt] = b[c]; }
    const unsigned base2 = (unsigned)((grow0 + 4 * hhb) * D_ + gcol0 + l31b);
#pragma unroll
    for (int mt = 0; mt < 2; ++mt)
#pragma unroll
      for (int i = 0; i < 16; ++i) {
        const int lr = lrow0 + mt * 32 + (i & 3) + 8 * (i >> 2) + 4 * hhb;
        const unsigned off = base2 + (unsigned)((mt * 32 + (i & 3) + 8 * (i >> 2)) * D_);
        const f32x2 st2 = *(const f32x2*)(stat + lr * 2);
#pragma unroll
        for (int nt = 0; nt < 4; ++nt) {
          float v = (acc[mt][nt][i] - st2.x) * st2.y * gg[nt] + bb[nt];
          Xout[off + nt * 32] = v; Xb[off + nt * 32] = f2bf(v);
        }
        asm volatile("" ::: "memory");
      }
  }
};

DI void store_tr(bf16_t* dstrow, int tok0, const f32x16& v, int hh, float mul) {
#pragma unroll
  for (int qd = 0; qd < 4; ++qd) {
    u32x2 p; p.x = pack2(v[4 * qd] * mul, v[4 * qd + 1] * mul); p.y = pack2(v[4 * qd + 2] * mul, v[4 * qd + 3] * mul);
    *(u32x2*)(dstrow + tok0 + 8 * qd + 4 * hh) = p;
  }
}

DI char* tr_stage(char* lds, int w) { return lds + 65536 + w * 8192; }
DI void tr_put(char* stg, int erow, const f32x16& v, int hh, float mul) {
#pragma unroll
  for (int qd = 0; qd < 4; ++qd) {
    u32x2 pk; pk.x = pack2(v[4 * qd] * mul, v[4 * qd + 1] * mul); pk.y = pack2(v[4 * qd + 2] * mul, v[4 * qd + 3] * mul);
    *(u32x2*)(stg + erow * 64 + (8 * qd + 4 * hh) * 2) = pk;
  }
}
template <int R>
DI void tr_flush(const char* stg, int row0, bf16_t* g, size_t grs, int lane) {
  const int r0 = lane >> 2, ch = lane & 3;
#pragma unroll
  for (int it = 0; it < R / 16; ++it) {
    const int r = it * 16 + r0;
    u32x4 v = *(const u32x4*)(stg + (row0 + r) * 64 + ch * 16);
    *(u32x4*)((char*)(g + (size_t)r * grs) + ch * 16) = v;
  }
}

struct EpiDAqkv {
  DI void pre(int, int, int, int, char*) {}
  bf16_t *Q, *K, *Vt; const float *cs, *sn;
  DI void operator()(f32x16 (&acc)[2][4], int grow0, int gcol0, int lane, int w, char* lds) {
    const int l31 = lane & 31, hh = lane >> 5;
    const int part = gcol0 >> 10, cin = gcol0 & 1023;
    if (part < 2) {
      bf16_t* dst = part == 0 ? Q : K;
#pragma unroll
      for (int mt = 0; mt < 2; ++mt)
#pragma unroll
        for (int pr = 0; pr < 2; ++pr)
#pragma unroll
          for (int i = 0; i < 16; ++i) {
            int row = grow0 + mt * 32 + crow(i, hh);
            float c = cs[row * 32 + l31], s = sn[row * 32 + l31];
            float x1 = acc[mt][2 * pr][i], x2 = acc[mt][2 * pr + 1][i];
            int col = cin + pr * 64 + l31;
            dst[(size_t)row * D_ + col] = f2bf(x1 * c - x2 * s);
            dst[(size_t)row * D_ + col + 32] = f2bf(x2 * c + x1 * s);
          }
    } else {
      const int b = grow0 >> 11, s0 = grow0 & 2047, h = cin >> 7;
      char* stg = tr_stage(lds, w);
#pragma unroll
      for (int mt = 0; mt < 2; ++mt) {
#pragma unroll
        for (int nt = 0; nt < 4; ++nt) tr_put(stg, nt * 32 + l31, acc[mt][nt], hh, 1.f);
        tr_flush<128>(stg, 0, Vt + ((size_t)(b * 8 + h) * 128) * S_ + s0 + mt * 32, S_, lane);
      }
    }
  }
};

struct EpiRETqkvg {
  DI void pre(int, int, int, int, char*) {}
  bf16_t *Q, *K, *Kdt, *Vrt, *G; const float *cs, *sn;
  DI void operator()(f32x16 (&acc)[2][4], int grow0, int gcol0, int lane, int w, char* lds) {
    const int l31 = lane & 31, hh = lane >> 5;
    const int b = grow0 >> 11, s0 = grow0 & 2047;
    if (gcol0 < 2048) {
      const int part = gcol0 >> 10, cin = gcol0 & 1023, h = cin >> 8, p0 = (cin & 255) >> 6;
      const float lg = logf(1.f - ex2(-5.f - (float)h));
      bf16_t* dst = part == 0 ? Q : K;
      const float mul = part == 0 ? 1.f : 0.0625f;
#pragma unroll
      for (int pr = 0; pr < 2; ++pr) {
        const int d = 32 * (p0 + pr) + l31;
        bf16_t* r1 = Kdt + ((size_t)(b * 4 + h) * 256 + d) * S_ + s0;
#pragma unroll
        for (int mt = 0; mt < 2; ++mt) {
          float c16[16], s16[16];
#pragma unroll
          for (int i = 0; i < 16; ++i) { const unsigned to = (unsigned)((grow0 + mt * 32 + crow(i, hh)) * 128 + d); c16[i] = cs[to]; s16[i] = sn[to]; }
#pragma unroll
          for (int qd = 0; qd < 4; ++qd) {
            float o1[4], o2[4];
#pragma unroll
            for (int e = 0; e < 4; ++e) {
              const int i = 4 * qd + e;
              const int row = grow0 + mt * 32 + 8 * qd + 4 * hh + e;
              float c = c16[i], s = s16[i];
              float x1 = acc[mt][2 * pr][i], x2 = acc[mt][2 * pr + 1][i];
              o1[e] = (x1 * c - x2 * s) * mul; o2[e] = (x2 * c + x1 * s) * mul;
              const unsigned oo = (unsigned)(row * D_ + h * 256 + d);
              dst[oo] = f2bf(o1[e]); dst[oo + 128] = f2bf(o2[e]);
            }
            if (part == 1) {
              const int rl = (mt * 32 + 8 * qd + 4 * hh) & 127;
              const int rb = (grow0 & 127) + rl;
#pragma unroll
              for (int e = 0; e < 4; ++e) { float kd = __expf((float)(127 - (rb + e)) * lg); o1[e] *= kd; o2[e] *= kd; }
              u32x2 p1, p2; p1.x = pack2(o1[0], o1[1]); p1.y = pack2(o1[2], o1[3]); p2.x = pack2(o2[0], o2[1]); p2.y = pack2(o2[2], o2[3]);
              *(u32x2*)(r1 + mt * 32 + 8 * qd + 4 * hh) = p1;
              *(u32x2*)(r1 + (size_t)128 * S_ + mt * 32 + 8 * qd + 4 * hh) = p2;
            }
          }
          asm volatile("" ::: "memory");
        }
      }
    } else if (gcol0 < 4096) {
      const int cin = gcol0 - 2048, h = cin >> 9;
      char* stg = tr_stage(lds, w);
#pragma unroll
      for (int mt = 0; mt < 2; ++mt) {
#pragma unroll
        for (int nt = 0; nt < 4; ++nt) tr_put(stg, nt * 32 + l31, acc[mt][nt], hh, 1.f);
        tr_flush<128>(stg, 0, Vrt + ((size_t)(b * 4 + h) * 512 + (cin & 511)) * S_ + s0 + mt * 32, S_, lane);
      }
    } else {
      const int cin = gcol0 - 4096;
#pragma unroll
      for (int mt = 0; mt < 2; ++mt)
#pragma unroll
        for (int nt = 0; nt < 4; ++nt)
#pragma unroll
          for (int i = 0; i < 16; ++i) { int row = grow0 + mt * 32 + crow(i, hh); G[(size_t)row * 2048 + cin + nt * 32 + l31] = f2bf(acc[mt][nt][i]); }
    }
  }
};

struct EpiPlain {
  DI void pre(int, int, int, int, char*) {}
  bf16_t* dst; float mul;
  DI void operator()(f32x16 (&acc)[2][4], int grow0, int gcol0, int lane, int w, char* lds) {
    const int l31 = lane & 31, hh = lane >> 5;
#pragma unroll
    for (int mt = 0; mt < 2; ++mt)
#pragma unroll
      for (int nt = 0; nt < 4; ++nt)
#pragma unroll
        for (int i = 0; i < 16; ++i) { int row = grow0 + mt * 32 + crow(i, hh); dst[(size_t)row * D_ + gcol0 + nt * 32 + l31] = f2bf(acc[mt][nt][i] * mul); }
  }
};

struct EpiXkv {
  DI void pre(int, int, int, int, char*) {}
  bf16_t *Kx, *Vxt;
  DI void operator()(f32x16 (&acc)[2][4], int grow0, int gcol0, int lane, int w, char* lds) {
    const int l31 = lane & 31, hh = lane >> 5;
    if (gcol0 < 1024) {
#pragma unroll
      for (int mt = 0; mt < 2; ++mt)
#pragma unroll
        for (int nt = 0; nt < 4; ++nt)
#pragma unroll
          for (int i = 0; i < 16; ++i) { int row = grow0 + mt * 32 + crow(i, hh); Kx[(size_t)row * D_ + gcol0 + nt * 32 + l31] = f2bf(acc[mt][nt][i]); }
    } else {
      const int cin = gcol0 - 1024, h = cin >> 8, b = grow0 >> 8, m0 = grow0 & 255;
      char* stg = tr_stage(lds, w);
#pragma unroll
      for (int mt = 0; mt < 2; ++mt) {
#pragma unroll
        for (int nt = 0; nt < 4; ++nt) tr_put(stg, nt * 32 + l31, acc[mt][nt], hh, 1.f);
        tr_flush<128>(stg, 0, Vxt + ((size_t)(b * 4 + h) * 256 + (cin & 255)) * 256 + m0 + mt * 32, 256, lane);
      }
    }
  }
};

template <class Epi>
DI void gemm_phase256(const bf16_t* A, int lda, const bf16_t* Bt, int K, int nN, char* lds, Epi& epi, int vb) {
  const int ntiles = 64 * nN;
  bool pre = false;
  for (int t = vb; t < ntiles; t += gridDim.x) {
    const int x = t & 7, L = t >> 3; const int pm = 8 * x + (L & 7), pn = L >> 3;
    const int t2 = t + gridDim.x; const bool hn = t2 < ntiles;
    const int x2 = t2 & 7, L2 = t2 >> 3; const int pm2 = 8 * x2 + (L2 & 7), pn2 = L2 >> 3;
    gemm_tile<4, 64>(A, lda, Bt, K, K, pm * 256, pn * 256, lds, epi, pre, hn, pm2 * 256, pn2 * 256);
    pre = hn;
  }
}
template <class Epi>
DI void gemm_phaseLNX(const bf16_t* A, int K, const bf16_t* Bt, char* lds, Epi& epi, int vb, bool blockdiag = false) {
  const int t = vb; const int x = t & 7, L = t >> 3; const int pm = 8 * x + (L & 7), pn = L >> 3;
  if (blockdiag) gemm_tile<4, 64>(A + pn * 256, K, Bt + pn * 256, K, 256, pm * 256, pn * 256, lds, epi);
  else gemm_tile<4, 64>(A, K, Bt, K, K, pm * 256, pn * 256, lds, epi);
}
template <class Epi>
DI void gemm_phaseLN(const bf16_t* A, int K, const bf16_t* Bt, char* lds, Epi& epi) {
  for (int t = blockIdx.x; t < 256; t += gridDim.x) gemm_tile<1, 32>(A, K, Bt, K, K, t * 64, 0, lds, epi);
}

DI int src_col(int perm, int n) {
  if (perm == 1) { int p = n >> 6, r = n & 63; return r < 32 ? 32 * p + r : 2816 + 32 * p + (r - 32); }
  if (perm == 3) {
    if (n >= 2048) return n;
    int part = n >> 10, h = (n & 1023) >> 8, n2 = n & 255, p = n2 >> 6, r = n2 & 63;
    int d = r < 32 ? 32 * p + r : 128 + 32 * p + (r - 32);
    return part * 1024 + h * 256 + d;
  }
  return n;
}

DI void phase_prologue(const Params& p, char* lds) {
  const int tid = launder(threadIdx.x);
  float* tile = (float*)lds;
  const int total = p.tile_start[p.njobs];
  int j = 0;
  for (int t = blockIdx.x; t < total; t += gridDim.x) {
    while (j + 1 < p.njobs && t >= p.tile_start[j + 1]) ++j;
    const TJob& jb = p.jobs[j];
    const int lt = t - p.tile_start[j];
    const int nkt = jb.K >> 7;
    const int k0 = (lt % nkt) << 7, n0 = (lt / nkt) << 7;
    __syncthreads();
    {
      const int nl = tid & 127, kb = tid >> 7;
      const int n = n0 + nl;
      if (jb.perm == 4) {
        const int g = n >> 8, gk = k0 >> 8;
#pragma unroll 8
        for (int i = 0; i < 32; ++i) { int kl = kb + 4 * i; int k = k0 + kl; tile[kl * 129 + nl] = (g == gk) ? jb.src[(size_t)g * 65536 + (size_t)(k & 255) * 256 + (n & 255)] : 0.f; }
      } else {
        const int sc = src_col(jb.perm, n);
        const float* sp = jb.src + (size_t)k0 * jb.lds_ + sc;
#pragma unroll 16
        for (int i = 0; i < 32; ++i) { int kl = kb + 4 * i; tile[kl * 129 + nl] = sp[(size_t)kl * jb.lds_]; }
      }
    }
    __syncthreads();
    {
      const int kl = tid & 127, nb = tid >> 7;
#pragma unroll 16
      for (int i = 0; i < 32; ++i) { int nl = nb + 4 * i; jb.dst[(size_t)(n0 + nl) * jb.ldd + k0 + kl] = f2bf(tile[kl * 129 + nl]); }
    }
  }
  const size_t gtid = (size_t)blockIdx.x * NT + tid, gsz = (size_t)gridDim.x * NT;
  for (size_t i = gtid; i < (size_t)T_ * D_ / 4; i += gsz) {
    f32x4 v = ((const f32x4*)p.x)[i];
    u32x2 o; o.x = pack2(v[0], v[1]); o.y = pack2(v[2], v[3]); ((u32x2*)p.Xb)[i] = o;
  }
  for (size_t i = gtid; i < (size_t)2048 * D_ / 4; i += gsz) {
    f32x4 v = ((const f32x4*)p.mem)[i];
    u32x2 o; o.x = pack2(v[0], v[1]); o.y = pack2(v[2], v[3]); ((u32x2*)p.memb)[i] = o;
  }
  const double TWO_PI = 6.283185307179586476925286766559;
  const double L2T = 13.287712379549449391481277717958;
  for (size_t i = gtid; i < (size_t)T_ * 32; i += gsz) {
    int t = (int)(i >> 5), k = (int)(i & 31);
    double inv = exp2(-(double)k * (1.0 / 32.0) * L2T);
    double ang = (double)p.pos[t] * inv; ang -= TWO_PI * rint(ang * (1.0 / TWO_PI));
    float a = (float)ang; p.cosD[i] = cosf(a); p.sinD[i] = sinf(a);
  }
  for (size_t i = gtid; i < (size_t)T_ * 128; i += gsz) {
    int t = (int)(i >> 7), k = (int)(i & 127);
    double inv = exp2(-(double)k * (1.0 / 127.0) * L2T);
    double ang = (double)p.pos[t] * inv; ang -= TWO_PI * rint(ang * (1.0 / TWO_PI));
    float a = (float)ang; p.cosR[i] = cosf(a); p.sinR[i] = sinf(a);
  }
}

template <int VSTR, bool DEFER = false>
DI void softmax_pv(f32x16 (&st)[2], float& m, float& l, f32x16 (&o)[4], const char* vt, int erow0, int lane) {
  const int l31 = lane & 31, hh = lane >> 5;
  float mx = -1e30f;
#pragma unroll
  for (int mt = 0; mt < 2; ++mt)
#pragma unroll
    for (int i = 0; i < 16; ++i) mx = fmaxf(mx, st[mt][i]);
  mx = xhalf_max(mx);
  if (DEFER) {
    constexpr float THR = 6.0f;
    if (__any(mx > m + THR)) {
      const float mn = fmaxf(m, mx);
      const float al = ex2(m - mn);
      m = mn;
      l *= al;
#pragma unroll
      for (int et = 0; et < 4; ++et)
#pragma unroll
        for (int i = 0; i < 16; ++i) o[et][i] *= al;
    }
    float ps = 0.f;
#pragma unroll
    for (int mt = 0; mt < 2; ++mt)
#pragma unroll
      for (int i = 0; i < 16; ++i) { float pv = ex2(st[mt][i] - m); st[mt][i] = pv; ps += pv; }
    l += ps;
  } else {
    const float mn = fmaxf(m, mx);
    const float al = ex2(m - mn);
    m = mn;
    float ps = 0.f;
#pragma unroll
    for (int mt = 0; mt < 2; ++mt)
#pragma unroll
      for (int i = 0; i < 16; ++i) { float pv = ex2(st[mt][i] - mn); st[mt][i] = pv; ps += pv; }
    l = l * al + ps;
#pragma unroll
    for (int et = 0; et < 4; ++et)
#pragma unroll
      for (int i = 0; i < 16; ++i) o[et][i] *= al;
  }
#pragma unroll
  for (int mt = 0; mt < 2; ++mt)
#pragma unroll
    for (int s = 0; s < 2; ++s) {
      u32x4 pb; pb.x = pack2(st[mt][8 * s], st[mt][8 * s + 1]); pb.y = pack2(st[mt][8 * s + 2], st[mt][8 * s + 3]);
      pb.z = pack2(st[mt][8 * s + 4], st[mt][8 * s + 5]); pb.w = pack2(st[mt][8 * s + 6], st[mt][8 * s + 7]);
      const bf16x8 bfrag = __builtin_bit_cast(bf16x8, pb);
      const int kb = mt * 32 + 16 * s + 4 * hh;
#pragma unroll
      for (int et = 0; et < 4; ++et) {
        const char* rp = vt + (erow0 + et * 32 + l31) * VSTR + kb * 2;
        s16x4 lo = *(const s16x4*)rp, hi = *(const s16x4*)(rp + 16);
        bf16x8 afrag = __builtin_shufflevector(lo, hi, 0, 1, 2, 3, 4, 5, 6, 7);
        o[et] = mfma(afrag, bfrag, o[et]);
      }
    }
}


DI f32x16 dot16_lds(const char* img, int row, int hh, const bf16x8 (&qf)[16], f32x16 acc) {
  const char* rp = img + row * 512; const int r15 = row & 15;
  bf16x8 a[2][4];
#pragma unroll
  for (int q = 0; q < 4; ++q) a[0][q] = *(const bf16x8*)(rp + ((((q * 2) + hh) ^ r15) << 4));
#pragma unroll
  for (int g = 0; g < 4; ++g) {
    if (g + 1 < 4) {
#pragma unroll
      for (int q = 0; q < 4; ++q) a[(g + 1) & 1][q] = *(const bf16x8*)(rp + (((((g + 1) * 4 + q) * 2 + hh) ^ r15) << 4));
    }
#pragma unroll
    for (int q = 0; q < 4; ++q) acc = mfma(a[g & 1][q], qf[g * 4 + q], acc);
    __builtin_amdgcn_sched_barrier(0);
  }
  return acc;
}
DI void phase_da_attn(const Params& p, int j, char* lds) {
  const int tid = launder(threadIdx.x), lane = tid & 63, w = tid >> 6, l31 = lane & 31, hh = lane >> 5;
  const int c = w & 1, qg = w >> 1;
  constexpr int KVB = 33792;
  float* cmb = (float*)(lds + 2 * KVB);
  float lam;
  {
    const float* lq = p.lam_q + j * 128; const float* lk = p.lam_k + j * 128;
    float v0 = lq[lane] * lk[lane], v1 = lq[64 + lane] * lk[64 + lane];
#pragma unroll
    for (int o = 32; o > 0; o >>= 1) { v0 += __shfl_xor(v0, o); v1 += __shfl_xor(v1, o); }
    lam = __expf(v0) - __expf(v1) + p.lam_init[j];
  }
  const float li = p.lam_init[j];
  const float sc = 0.125f * LOG2E;
  const bf16_t* Q = p.Q; const bf16_t* K = p.Kb; const bf16_t* Vt = p.Vt;
  for (int it = blockIdx.x; it < 1024; it += gridDim.x) {
    const int jj = it & 255, kr = it >> 8, g = jj >> 6, bh = jj & 63;
    const int qb = kr == 0 ? 15 - g : kr == 1 ? 8 + g : kr == 2 ? 7 - g : g;
    const int b = bh >> 3, h = bh & 7;
    const int q0 = qb * 128 + qg * 32;
    const int myq = q0 + l31;
    const size_t tokb = (size_t)b * S_;
    bf16x8 qf[4];
#pragma unroll
    for (int kk = 0; kk < 4; ++kk) qf[kk] = *(const bf16x8*)(Q + (tokb + myq) * D_ + h * 128 + c * 64 + kk * 16 + 8 * hh);
    f32x16 o[4];
#pragma unroll
    for (int et = 0; et < 4; ++et) o[et] = zero16();
    float m = -1e30f, l = 0.f;
    const int nkt = 2 * (qb + 1);
    u32x4 rk[2], rv[2];
    auto gload = [&](int kt) {
#pragma unroll
      for (int i = 0; i < 2; ++i) {
        int idx = tid + i * NT;
        { int row = idx >> 4, ch = idx & 15; rk[i] = *(const u32x4*)(K + (tokb + kt * 64 + row) * D_ + h * 128 + ch * 8); }
        { int row = idx >> 3, ch = idx & 7; rv[i] = *(const u32x4*)(Vt + ((size_t)(b * 8 + h) * 128 + row) * S_ + kt * 64 + ch * 8); }
      }
    };
    auto lwrite = [&](int buf) {
      char* kt_w = lds + buf * KVB; char* vt_w = kt_w + 16384;
#pragma unroll
      for (int i = 0; i < 2; ++i) {
        int idx = tid + i * NT;
        { int row = idx >> 4, ch = idx & 15; *(u32x4*)(kt_w + row * 256 + ((ch ^ (row & 15)) << 4)) = rk[i]; }
        { int row = idx >> 3, ch = idx & 7; char* d = vt_w + row * 136 + ch * 16; u32x2 a = {rv[i].x, rv[i].y}, bq = {rv[i].z, rv[i].w}; *(u32x2*)d = a; *(u32x2*)(d + 8) = bq; }
      }
    };
    __syncthreads();
    gload(0); lwrite(0);
    if (nkt > 1) gload(1);
    __syncthreads();
    for (int kt = 0; kt < nkt; ++kt) {
      if (kt + 1 < nkt) lwrite((kt + 1) & 1);
      if (kt + 2 < nkt) gload(kt + 2);
      const char* kt_l = lds + (kt & 1) * KVB; const char* vt_l = kt_l + 16384;
      if (kt * 64 <= q0 + 31) {
        f32x16 st[2];
#pragma unroll
        for (int mt = 0; mt < 2; ++mt) {
          st[mt] = zero16();
          const int row = mt * 32 + l31;
#pragma unroll
          for (int kk = 0; kk < 4; ++kk) {
            int ch = c * 8 + kk * 2 + hh;
            bf16x8 a = *(const bf16x8*)(kt_l + row * 256 + ((ch ^ (row & 15)) << 4));
            st[mt] = mfma(a, qf[kk], st[mt]);
          }
        }
        const bool diag = kt * 64 + 63 > q0;
#pragma unroll
        for (int mt = 0; mt < 2; ++mt)
#pragma unroll
          for (int i = 0; i < 16; ++i) {
            float s = st[mt][i] * sc;
            if (diag) { int key = kt * 64 + mt * 32 + crow(i, hh); if (key > myq) s = -1e30f; }
            st[mt][i] = s;
          }
        softmax_pv<136, true>(st, m, l, o, vt_l, 0, lane);
      }
      __syncthreads();
    }
    l = xhalf_sum(l);
    const float inv = 1.f / l;
    if (c == 1) {
#pragma unroll
      for (int et = 0; et < 4; ++et)
#pragma unroll
        for (int i = 0; i < 16; ++i) cmb[(qg * 128 + et * 32 + crow(i, hh)) * 32 + l31] = o[et][i] * inv;
    }
    __syncthreads();
    if (c == 0) {
      float ss = 0.f;
#pragma unroll
      for (int et = 0; et < 4; ++et)
#pragma unroll
        for (int i = 0; i < 16; ++i) { float v = o[et][i] * inv - lam * cmb[(qg * 128 + et * 32 + crow(i, hh)) * 32 + l31]; o[et][i] = v; ss += v * v; }
      ss = xhalf_sum(ss);
      const float r = rsqrtf(ss * (1.f / 128.f) + LN_EPS) * (1.f - li);
      bf16_t* orow = p.Oa + (tokb + myq) * D_ + h * 128;
      const float* sg = p.subln_g + j * 128;
#pragma unroll
      for (int et = 0; et < 4; ++et)
#pragma unroll
        for (int qd = 0; qd < 4; ++qd) {
          int e = et * 32 + 8 * qd + 4 * hh;
          f32x4 gv = *(const f32x4*)(sg + e);
          u32x2 pk; pk.x = pack2(o[et][4 * qd] * r * gv[0], o[et][4 * qd + 1] * r * gv[1]); pk.y = pack2(o[et][4 * qd + 2] * r * gv[2], o[et][4 * qd + 3] * r * gv[3]);
          *(u32x2*)(orow + e) = pk;
        }
    }
  }
}

DI void phase_xa_attn(const Params& p, int layer, char* lds) {
  const int tid = launder(threadIdx.x), lane = tid & 63, w = tid >> 6, l31 = lane & 31, hh = lane >> 5;
  const int eh = w & 1, qg = w >> 1;
  const bf16_t* Q = p.Q; const bf16_t* K = p.Kx + (size_t)layer * 2048 * D_; const bf16_t* Vt = p.Vxt + (size_t)layer * 32 * 256 * 256;
  for (int it = blockIdx.x; it < 512; it += gridDim.x) {
    const int h = it & 3, qt = it >> 2, b = qt >> 4;
    const size_t tok = (size_t)qt * 128 + qg * 32 + l31;
    bf16x8 qf[16];
#pragma unroll
    for (int kk = 0; kk < 16; ++kk) qf[kk] = *(const bf16x8*)(Q + tok * D_ + h * 256 + kk * 16 + 8 * hh);
    f32x16 o[4];
#pragma unroll
    for (int et = 0; et < 4; ++et) o[et] = zero16();
    float m = -1e30f, l = 0.f;
    u32x4 rv[4];
    auto kdma = [&](int kt) {
      char* kb = lds + (kt & 1) * 32768;
#pragma unroll 1
      for (int i = 0; i < 4; ++i) {
        const int pc = __builtin_amdgcn_readfirstlane(w) * 4 + i; const int row = 2 * pc + (lane >> 5); const int cc = (lane & 31) ^ (row & 15);
        __builtin_amdgcn_global_load_lds((const unsigned*)(K + ((size_t)b * 256 + kt * 64 + row) * D_ + h * 256 + cc * 8), (__attribute__((address_space(3))) unsigned*)(kb + pc * 1024), 16, 0, 0);
      }
    };
    auto vload = [&](int kt) {
#pragma unroll
      for (int i = 0; i < 4; ++i) { int idx = tid + i * NT; int row = idx >> 3, ch = idx & 7; rv[i] = *(const u32x4*)(Vt + ((size_t)(b * 4 + h) * 256 + row) * 256 + kt * 64 + ch * 8); }
    };
    auto vwrite = [&](int kt) {
      char* vb_ = lds + 65536 + (kt & 1) * 34816;
#pragma unroll
      for (int i = 0; i < 4; ++i) { int idx = tid + i * NT; int row = idx >> 3, ch = idx & 7; char* d = vb_ + row * 136 + ch * 16; u32x2 a = {rv[i].x, rv[i].y}, bq = {rv[i].z, rv[i].w}; *(u32x2*)d = a; *(u32x2*)(d + 8) = bq; }
    };
    __syncthreads();
    kdma(0); vload(0); vwrite(0);
    wait_vm0();
    __syncthreads();
    for (int kt = 0; kt < 4; ++kt) {
      if (kt + 1 < 4) kdma(kt + 1);
      const char* kt_l = lds + (kt & 1) * 32768; const char* vt_l = lds + 65536 + (kt & 1) * 34816;
      f32x16 st[2];
      const int l31k = launder(l31);
#pragma unroll
      for (int mt = 0; mt < 2; ++mt) {
        st[mt] = dot16_lds(kt_l, mt * 32 + l31k, hh, qf, zero16());
      }
#pragma unroll
      for (int mt = 0; mt < 2; ++mt)
#pragma unroll
        for (int i = 0; i < 16; ++i) st[mt][i] *= LOG2E;
      softmax_pv<136>(st, m, l, o, vt_l, eh * 128, lane);
      if (kt + 1 < 4) { vload(kt + 1); vwrite(kt + 1); }
      wait_vm0();
      __syncthreads();
    }
    l = xhalf_sum(l);
    const float inv = 1.f / l;
    char* stg = lds + w * 8704;
#pragma unroll
    for (int et = 0; et < 4; ++et)
#pragma unroll
      for (int qd = 0; qd < 4; ++qd) {
        int e = et * 32 + 8 * qd + 4 * hh;
        u32x2 pk; pk.x = pack2(o[et][4 * qd] * inv, o[et][4 * qd + 1] * inv); pk.y = pack2(o[et][4 * qd + 2] * inv, o[et][4 * qd + 3] * inv);
        *(u32x2*)(stg + l31 * 272 + e * 2) = pk;
      }
    {
      bf16_t* obase = p.Oa + ((size_t)qt * 128 + qg * 32) * D_ + h * 256 + eh * 128;
      const int r0 = lane >> 4, ch = lane & 15;
#pragma unroll 2
      for (int it = 0; it < 8; ++it) {
        const int r = it * 4 + r0;
        u32x4 v = *(const u32x4*)(stg + r * 272 + ch * 16);
        *(u32x4*)(obase + (size_t)r * D_ + ch * 8) = v;
      }
    }
  }
}

DI void phase_ret(const Params& p, char* lds) {
  const int tid = launder(threadIdx.x), lane = tid & 63, w = tid >> 6, l31 = lane & 31, hh = lane >> 5;
  char* k_l = lds;
  char* v_l = lds + 65536;
  char* r_l = lds + 65536 + 16896;
  const int et = w & 1, itl = w >> 1;
  for (int it = blockIdx.x; it < 256; it += gridDim.x) {
    const int xq = it & 7, rq = it >> 3;
    const int sl = rq & 7, bh = xq * 4 + (rq >> 3), b = bh >> 2, h = bh & 3;
    const float lg = logf(1.f - ex2(-5.f - (float)h));
    const float lg2 = lg * LOG2E;
    const float cd = ex2(128.f * lg2);
    const size_t tokb = (size_t)b * S_;
    f32x16 R[2]; R[0] = zero16(); R[1] = zero16();
    const int myi = itl * 32 + l31;
    const float qd = ex2((float)(myi + 1) * lg2);
    for (int ck = 0; ck < 16; ++ck) {
      const int s0 = ck * 128;
      const int l31k = launder(l31), hhk = launder(hh);
      __syncthreads();
#pragma unroll 1
      for (int i = 0; i < 8; ++i) {
        const int pc = __builtin_amdgcn_readfirstlane(w) * 8 + i; const int row = 2 * pc + (lane >> 5); const int c = (lane & 31) ^ (row & 15);
        __builtin_amdgcn_global_load_lds((const unsigned*)(p.Kb + (tokb + s0 + row) * D_ + h * 256 + c * 8), (__attribute__((address_space(3))) unsigned*)(k_l + pc * 1024), 16, 0, 0);
      }
#pragma unroll
      for (int i = 0; i < 2; ++i) {
        int idx = tid + i * NT; int row = idx >> 4, ch = idx & 15;
        u32x4 v = *(const u32x4*)(p.Vrt + ((size_t)bh * 512 + sl * 64 + row) * S_ + s0 + ch * 8);
        char* d = v_l + row * 264 + ch * 16; u32x2 a = {v.x, v.y}, bq = {v.z, v.w}; *(u32x2*)d = a; *(u32x2*)(d + 8) = bq;
      }
      bf16x8 qf[16];
#pragma unroll
      for (int kk = 0; kk < 16; ++kk) qf[kk] = *(const bf16x8*)(p.Q + (tokb + s0 + myi) * D_ + h * 256 + kk * 16 + 8 * hhk);
      wait_vm0();
      __syncthreads();
      f32x16 o = zero16();
      if (ck > 0) {
        o = dot16_lds(r_l, et * 32 + l31k, hhk, qf, o);
#pragma unroll
        for (int i = 0; i < 16; ++i) o[i] *= qd;
      }
      for (int jt = 0; jt <= itl; ++jt) {
        f32x16 st = zero16();
        const int relb = launder(itl * 32 + l31k - jt * 32 - 4 * hhk);
        st = dot16_lds(k_l, jt * 32 + l31k, hhk, qf, st);
#pragma unroll
        for (int i = 0; i < 16; ++i) { int rel = relb - ((i & 3) + 8 * (i >> 2)); st[i] = rel >= 0 ? st[i] * ex2((float)rel * lg2) : 0.f; }
#pragma unroll
        for (int s = 0; s < 2; ++s) {
          u32x4 pb; pb.x = pack2(st[8 * s], st[8 * s + 1]); pb.y = pack2(st[8 * s + 2], st[8 * s + 3]); pb.z = pack2(st[8 * s + 4], st[8 * s + 5]); pb.w = pack2(st[8 * s + 6], st[8 * s + 7]);
          const bf16x8 bfrag = __builtin_bit_cast(bf16x8, pb);
          const char* rp = v_l + (et * 32 + l31k) * 264 + (jt * 32 + 16 * s + 4 * hhk) * 2;
          s16x4 lo = *(const s16x4*)rp, hi = *(const s16x4*)(rp + 16);
          bf16x8 afrag = __builtin_shufflevector(lo, hi, 0, 1, 2, 3, 4, 5, 6, 7);
          o = mfma(afrag, bfrag, o);
        }
      }
      {
        bf16_t* orow = p.Or + (tokb + s0 + myi) * 2048 + h * 512 + sl * 64 + et * 32;
#pragma unroll
        for (int q4 = 0; q4 < 4; ++q4) {
          u32x2 pk; pk.x = pack2(o[4 * q4], o[4 * q4 + 1]); pk.y = pack2(o[4 * q4 + 2], o[4 * q4 + 3]);
          *(u32x2*)(orow + 8 * q4 + 4 * hhk) = pk;
        }
      }
      asm volatile("" ::: "memory");
      if (ck < 15) {
        const bf16_t* kdr = p.Vt + ((size_t)bh * 256 + w * 32 + l31k) * S_ + s0;
        bf16x8 ka[8];
#pragma unroll
        for (int kk = 0; kk < 8; ++kk) ka[kk] = *(const bf16x8*)(kdr + kk * 16 + 8 * hhk);
#pragma unroll
        for (int nt = 0; nt < 2; ++nt) {
#pragma unroll
          for (int i = 0; i < 16; ++i) R[nt][i] *= cd;
#pragma unroll
          for (int kk = 0; kk < 8; ++kk) {
            const char* rp = v_l + (nt * 32 + l31k) * 264 + (kk * 16 + 8 * hhk) * 2;
            s16x4 lo = *(const s16x4*)rp, hi = *(const s16x4*)(rp + 8);
            bf16x8 bfrag = __builtin_shufflevector(lo, hi, 0, 1, 2, 3, 4, 5, 6, 7);
            R[nt] = mfma(ka[kk], bfrag, R[nt]);
          }
        }
        __syncthreads();
#pragma unroll
        for (int nt = 0; nt < 2; ++nt) {
          const int e = nt * 32 + l31k;
#pragma unroll
          for (int q4 = 0; q4 < 4; ++q4) {
            int d = w * 32 + 8 * q4 + 4 * hhk;
            u32x2 pk; pk.x = pack2(R[nt][4 * q4], R[nt][4 * q4 + 1]); pk.y = pack2(R[nt][4 * q4 + 2], R[nt][4 * q4 + 3]);
            *(u32x2*)(r_l + e * 512 + (((d >> 3) ^ (e & 15)) << 4) + (d & 7) * 2) = pk;
          }
        }
      }
    }
  }
}

DI void phase_ret_norm(const Params& p) {
  const int tid = launder(threadIdx.x), lane = tid & 63, w = tid >> 6;
  const int nxw = ((int)gridDim.x >> 3) * 8;
  for (int lr = ((int)blockIdx.x >> 3) * 8 + w; lr < 8192 && (int)blockIdx.x < ((int)gridDim.x & ~7); lr += nxw) {
    const int r = (blockIdx.x & 7) * 8192 + lr;
    bf16_t* op = p.Or + (size_t)r * 512 + lane * 8;
    const bf16_t* gp = p.G + (size_t)r * 512 + lane * 8;
    u32x4 ov = *(const u32x4*)op, gv = *(const u32x4*)gp;
    float o[8], g[8];
#pragma unroll
    for (int i = 0; i < 4; ++i) { o[2 * i] = __uint_as_float(ov[i] << 16); o[2 * i + 1] = __uint_as_float(ov[i] & 0xffff0000u); g[2 * i] = __uint_as_float(gv[i] << 16); g[2 * i + 1] = __uint_as_float(gv[i] & 0xffff0000u); }
    float s = 0.f;
#pragma unroll
    for (int i = 0; i < 8; ++i) s += o[i];
#pragma unroll
    for (int of = 32; of > 0; of >>= 1) s += __shfl_xor(s, of);
    const float mu = s * (1.f / 512.f);
    float q = 0.f;
#pragma unroll
    for (int i = 0; i < 8; ++i) { float d = o[i] - mu; q += d * d; }
#pragma unroll
    for (int of = 32; of > 0; of >>= 1) q += __shfl_xor(q, of);
    const float rs = rsqrtf(q * (1.f / 512.f) + LN_EPS);
    u32x4 res;
#pragma unroll
    for (int i = 0; i < 4; ++i) {
      float a = (o[2 * i] - mu) * rs * (g[2 * i] / (1.f + __expf(-g[2 * i])));
      float b2 = (o[2 * i + 1] - mu) * rs * (g[2 * i + 1] / (1.f + __expf(-g[2 * i + 1])));
      res[i] = pack2(a, b2);
    }
    *(u32x4*)op = res;
  }
}

DI void phase_pool(const Params& p) {
  const size_t gtid = (size_t)blockIdx.x * NT + launder(threadIdx.x), gsz = (size_t)gridDim.x * NT;
  for (size_t i = gtid; i < (size_t)T_ * 256; i += gsz) {
    const int t = (int)(i >> 8), c4 = (int)(i & 255);
    const int wdw = 2 << (c4 >> 6);
    const int s = t & (S_ - 1);
    const int n = (s + 1) < wdw ? (s + 1) : wdw;
    const f32x4 x0 = ((const f32x4*)p.X)[i];
    f32x4 sum = x0;
    for (int u = 1; u < n; ++u) sum += ((const f32x4*)p.X)[i - (size_t)u * 256];
    const float rn = 1.f / (float)n;
    f32x4 r = sum * rn - x0;
    u32x2 o; o.x = pack2(r[0], r[1]); o.y = pack2(r[2], r[3]);
    ((u32x2*)p.Oa)[i] = o;
  }
}


#define XB_TMO      128
#define XB_XCNT(j)  (256  + 64 * (j))
#define XB_XSUB(j)  (1280 + 64 * (j))
#define XB_XGEN(j)  (2304 + 64 * (j))
#define XB_TOP      3328
#define XB_TOPGEN   3392
#define XCD_BAR_WORDS 3456
#define XB_SPIN_CAP (1u << 20)
#define LAS __attribute__((address_space(3)))
DI unsigned xb_ld(unsigned* p)              { return __hip_atomic_load(p, __ATOMIC_RELAXED, __HIP_MEMORY_SCOPE_AGENT); }
DI unsigned xb_add(unsigned* p, unsigned v) { return __hip_atomic_fetch_add(p, v, __ATOMIC_RELAXED, __HIP_MEMORY_SCOPE_AGENT); }
DI unsigned xb_xcc_id() { return (unsigned)__builtin_amdgcn_s_getreg((3 << 11) | 20) & 0xFu; }
#define XB_SPIN(cond, bar) do { unsigned _sp = 0; while (cond) { __builtin_amdgcn_s_sleep(1); \
    if ((++_sp & 255u) == 0u) { if (xb_ld(&(bar)[XB_TMO])) break; if (_sp > XB_SPIN_CAP) { atomicAdd(&(bar)[XB_TMO], 1u); break; } } } } while (0)
struct XcdBarrier { unsigned* bar; unsigned x; volatile LAS unsigned* st; };
DI XcdBarrier xcd_barrier_post(unsigned* bar, volatile LAS unsigned* st) {
  XcdBarrier b; b.bar = bar; b.x = xb_xcc_id(); b.st = st;
  if (threadIdx.x == 0) (void)xb_add(&bar[XB_XCNT(b.x)], 1u);
  return b;
}
DI void xcd_barrier_complete(unsigned* bar, unsigned x, unsigned& nloc, unsigned& nx) {
  const unsigned G = gridDim.x * gridDim.y * gridDim.z;
  unsigned sum, cnt, mine, sp = 0u;
  for (;;) {
    sum = 0u; cnt = 0u; mine = 0u;
#pragma unroll
    for (unsigned j = 0; j < 16; ++j) { const unsigned c = xb_ld(&bar[XB_XCNT(j)]); sum += c; cnt += (c > 0u) ? 1u : 0u; mine = (j == x) ? c : mine; }
    if (sum == G) break;
    __builtin_amdgcn_s_sleep(1);
    if ((++sp & 255u) == 0u) { if (xb_ld(&bar[XB_TMO])) break; if (sp > XB_SPIN_CAP) { atomicAdd(&bar[XB_TMO], 1u); break; } }
  }
  nloc = mine > 0u ? mine : 1u; nx = cnt > 0u ? cnt : 1u;
}
DI void xcd_barrier(const XcdBarrier& b) {
  asm volatile("s_waitcnt vmcnt(0)" ::: "memory");
  __syncthreads();
  if (threadIdx.x == 0) {
    unsigned* bar = b.bar;
    __builtin_amdgcn_s_waitcnt(0);
    unsigned nloc = b.st[0], nx = b.st[1];
    if (nloc == 0u) { xcd_barrier_complete(bar, b.x, nloc, nx); b.st[0] = nloc; b.st[1] = nx; }
    const unsigned old = xb_add(&bar[XB_XSUB(b.x)], 1u);
    const unsigned gen = old / nloc;
    if (old + 1u == (gen + 1u) * nloc) {
      __builtin_amdgcn_fence(__ATOMIC_RELEASE, "agent");
      asm volatile("s_waitcnt vmcnt(0)" ::: "memory");
      const unsigned og = xb_add(&bar[XB_TOP], 1u);
      const unsigned tg = og / nx;
      if (og + 1u == (tg + 1u) * nx) xb_add(&bar[XB_TOPGEN], 1u);
      else XB_SPIN(xb_ld(&bar[XB_TOPGEN]) == tg, bar);
      __builtin_amdgcn_fence(__ATOMIC_ACQUIRE, "agent");
      xb_add(&bar[XB_XGEN(b.x)], 1u);
      asm volatile("s_waitcnt vmcnt(0)" ::: "memory");
    } else {
      XB_SPIN(xb_ld(&bar[XB_XGEN(b.x)]) == gen, bar);
      __builtin_amdgcn_fence(__ATOMIC_ACQUIRE, "agent");
      asm volatile("s_waitcnt vmcnt(0)" ::: "memory");
    }
  }
  __syncthreads();
}

__global__ void __launch_bounds__(NT) fwd_megakernel(Params p) {
  __shared__ __attribute__((aligned(16))) char lds[LDS_BYTES];
  cg::grid_group grid = cg::this_grid();
  __shared__ uint4 xb_words;
  if (threadIdx.x == 0) xb_words = make_uint4(0u, 0u, 0u, 0u);
  __syncthreads();
  const XcdBarrier xb = xcd_barrier_post(p.bar, (volatile LAS unsigned*)&xb_words);
  if (threadIdx.x == 0) { const unsigned r = xb_add(&p.xrank[xb.x * 64], 1u); __hip_atomic_store(&p.xrank[(8 + blockIdx.x) * 64], r * 8u + xb.x, __ATOMIC_RELAXED, __HIP_MEMORY_SCOPE_AGENT); }

  for (int rep_ = 0; rep_ < ((PROBE_DUP & 32) ? 2 : 1); ++rep_) { phase_prologue(p, lds); }
  if (p.njobs < 0) grid.sync();
  xcd_barrier(xb);
  int vb = blockIdx.x;
  {
    bool even = gridDim.x == 256;
#pragma unroll
    for (int q = 0; q < 8; ++q) even = even && (xb_ld(&p.xrank[q * 64]) == 32u);
    if (even) vb = (int)(xb_ld(&p.xrank[(8 + blockIdx.x) * 64]));
  }
  for (int st = -1; st < 16; ++st) {
    const int i = st >> 2, k = st & 3;
    const int mx = i % 3, j = i / 3;
    const int nsp = st < 0 ? 1 : (k == 0 || k == 3) ? 2 : k == 2 ? 3 : (mx == 0 ? 3 : mx == 1 ? 2 : 4);
    for (int sp = 0; sp < nsp; ++sp) {
      if (st < 0) {
        for (int t = blockIdx.x; t < 256; t += gridDim.x) {
          int layer = t >> 6, pm = t & 7, pn = (t >> 3) & 7;
          EpiXkv e{p.Kx + (size_t)layer * 2048 * D_, p.Vxt + (size_t)layer * 32 * 256 * 256};
          gemm_tile<4, 64>(p.memb, D_, p.wxkv[layer], D_, D_, pm * 256, pn * 256, lds, e);
        }
      } else if (k == 0 || k == 3) {
        const int f = k == 3 ? 1 : 0;
        if (sp == 0) {
          EpiSwiglu e1{p.H};
          for (int rep_ = 0; rep_ < ((PROBE_DUP & 1) ? 2 : 1); ++rep_) {
            gemm_phase256(p.Xb, D_, p.win[i * 2 + f], D_, 20, lds, e1, vb);
            for (int t = vb; t < 256; t += gridDim.x) {
              const int x = t & 7, L = t >> 3; const int pm = 8 * x + (L & 7), pnh = L >> 3;
              gemm_tile<4, 64, EpiSwiglu, 2>(p.Xb, D_, p.win[i * 2 + f], D_, D_, pm * 256, 5120 + pnh * 128, lds, e1);
            }
          }
        } else {
          const int lnidx = i * 4 + (f ? 3 : 0);
          EpiLNX e2{(st == 0) ? p.x : (const float*)p.X, (st == 15) ? p.out : p.X, p.Xb, nullptr, nullptr, p.ln_g + lnidx * D_, p.ln_b + lnidx * D_, 0.5f, p.xstat, p.xcnt, p.bar + XB_TMO, 4u * (unsigned)(lnidx + 1)};
          gemm_phaseLNX(p.H, F_, p.wout[i * 2 + f], lds, e2, vb);
        }
      } else if (k == 1) {
        const int lnidx = i * 4 + 1;
        const bool last = sp == nsp - 1;
        if (last) {
          const bf16_t* A = mx == 2 ? p.Or : p.Oa;
          const int K = mx == 2 ? 2048 : D_;
          const bf16_t* W = mx == 0 ? p.wdo[j] : mx == 1 ? p.wpool : p.wreto;
          EpiLNX e2{p.X, p.X, p.Xb, mx == 1 ? p.pool_b : nullptr, mx == 1 ? p.pool_scale : nullptr, p.ln_g + lnidx * D_, p.ln_b + lnidx * D_, 1.f, p.xstat, p.xcnt, p.bar + XB_TMO, 4u * (unsigned)(lnidx + 1)};
          gemm_phaseLNX(A, K, W, lds, e2, vb, mx == 1);
        } else if (mx == 0) {
          if (sp == 0) { EpiDAqkv e1{p.Q, p.Kb, p.Vt, p.cosD, p.sinD}; gemm_phase256(p.Xb, D_, p.wqkv[j], D_, 12, lds, e1, vb); }
          else for (int rep_ = 0; rep_ < ((PROBE_DUP & 4) ? 2 : 1); ++rep_) { phase_da_attn(p, j, lds); }
        } else if (mx == 1) {
          phase_pool(p);
        } else {
          if (sp == 0) { EpiRETqkvg e1{p.Q, p.Kb, p.Vt, p.Vrt, p.G, p.cosR, p.sinR}; gemm_phase256(p.Xb, D_, p.wret, D_, 24, lds, e1, vb); }
          else if (sp == 1) for (int rep_ = 0; rep_ < ((PROBE_DUP & 8) ? 2 : 1); ++rep_) { phase_ret(p, lds); }
          else phase_ret_norm(p);
        }
      } else {
        const int lnidx = i * 4 + 2;
        if (sp == 0) { EpiPlain e1{p.Q, 0.0625f}; gemm_phase256(p.Xb, D_, p.wxq[i], D_, 4, lds, e1, vb); }
        else if (sp == 1) for (int rep_ = 0; rep_ < ((PROBE_DUP & 16) ? 2 : 1); ++rep_) { phase_xa_attn(p, i, lds); }
        else { EpiLNX e2{p.X, p.X, p.Xb, nullptr, nullptr, p.ln_g + lnidx * D_, p.ln_b + lnidx * D_, 1.f, p.xstat, p.xcnt, p.bar + XB_TMO, 4u * (unsigned)(lnidx + 1)}; gemm_phaseLNX(p.Oa, D_, p.wxo[i], lds, e2, vb); }
      }
      if (!(st == 15 && sp == nsp - 1)) xcd_barrier(xb);
    }
  }
}

extern "C" void kernel_launch(void* const* d_in, const int* in_sizes, int n_in, void* d_out, int out_size, void* d_ws, size_t ws_size, hipStream_t stream) {
  (void)in_sizes; (void)n_in; (void)out_size;
  static Params p;
  static int grid_blocks = 0;
  static bool ok = true;
  if (!grid_blocks) {
    int dev = 0, cus = 0, per_cu = 0;
    hipGetDevice(&dev);
    hipDeviceGetAttribute(&cus, hipDeviceAttributeMultiprocessorCount, dev);
    hipOccupancyMaxActiveBlocksPerMultiprocessor(&per_cu, fwd_megakernel, NT, 0);
    if (per_cu < 1) per_cu = 1;
    grid_blocks = 256;
    if (cus < 256) { fprintf(stderr, "needs 256 CUs, device has %d\n", cus); ok = false; }
  }
  std::memset((void*)&p, 0, sizeof(p));
  const float* x = (const float*)d_in[0]; const float* mem = (const float*)d_in[1]; const int* pos = (const int*)d_in[2];
  const float* ffn_w_in = (const float*)d_in[3]; const float* ffn_w_out = (const float*)d_in[4];
  const float* ln_g = (const float*)d_in[5]; const float* ln_b = (const float*)d_in[6];
  const float* da_w_qkv = (const float*)d_in[7]; const float* da_w_o = (const float*)d_in[8];
  const float* da_lam_q = (const float*)d_in[9]; const float* da_lam_k = (const float*)d_in[10]; const float* da_subln_g = (const float*)d_in[11];
  const float* pool_w = (const float*)d_in[12]; const float* pool_b = (const float*)d_in[13]; const float* pool_scale = (const float*)d_in[14];
  const float* ret_w_qkvg = (const float*)d_in[15]; const float* ret_w_o = (const float*)d_in[16];
  const float* xa_wq = (const float*)d_in[17]; const float* xa_wkv = (const float*)d_in[18]; const float* xa_wo = (const float*)d_in[19];
  p.x = x; p.mem = mem; p.pos = pos; p.ln_g = ln_g; p.ln_b = ln_b; p.lam_q = da_lam_q; p.lam_k = da_lam_k; p.subln_g = da_subln_g; p.pool_b = pool_b; p.pool_scale = pool_scale;
  p.out = (float*)d_out;
  char* ws = (char*)d_ws; size_t off = 0;
  auto alloc = [&](size_t bytes) { char* r = ws + off; off += (bytes + 255) & ~(size_t)255; return r; };
  const size_t U = (size_t)T_ * 1024 * 2;
  p.bar = (unsigned*)alloc(XCD_BAR_WORDS * 4 + 64 * 256 + 264 * 256);
  p.xcnt = p.bar + XCD_BAR_WORDS;
  p.xrank = p.xcnt + 64 * 64;
  p.xstat = (u64_t*)alloc((size_t)64 * 256 * 4 * 8);
  p.X = (float*)alloc((size_t)T_ * D_ * 4); p.Xb = (bf16_t*)alloc(U); p.memb = (bf16_t*)alloc((size_t)2048 * D_ * 2);
  p.cosD = (float*)alloc((size_t)T_ * 32 * 4); p.sinD = (float*)alloc((size_t)T_ * 32 * 4);
  p.cosR = (float*)alloc((size_t)T_ * 128 * 4); p.sinR = (float*)alloc((size_t)T_ * 128 * 4);
  p.Kx = (bf16_t*)alloc((size_t)4 * 2048 * D_ * 2); p.Vxt = (bf16_t*)alloc((size_t)4 * 2048 * D_ * 2);
  char* big = alloc(10 * U);
  p.H = (bf16_t*)big; p.Q = (bf16_t*)big; p.Kb = (bf16_t*)(big + U); p.Vt = (bf16_t*)(big + 2 * U); p.Oa = (bf16_t*)(big + 3 * U);
  p.Vrt = (bf16_t*)(big + 4 * U); p.G = (bf16_t*)(big + 6 * U); p.Or = (bf16_t*)(big + 8 * U);
  int nj = 0; int tiles = 0;
  auto job = [&](const float* src, int K, int N, int lds_, int perm) {
    bf16_t* dst = (bf16_t*)alloc((size_t)K * N * 2);
    TJob& j = p.jobs[nj]; j.src = src; j.dst = dst; j.K = K; j.N = N; j.lds_ = lds_; j.ldd = K; j.perm = perm; j.pad = 0;
    p.tile_start[nj] = tiles; tiles += (K / 128) * (N / 128); ++nj; return (const bf16_t*)dst;
  };
  for (int i = 0; i < 8; ++i) {
    p.win[i] = job(ffn_w_in + (size_t)i * D_ * 2 * F_, D_, 2 * F_, 2 * F_, 1);
    p.wout[i] = job(ffn_w_out + (size_t)i * F_ * D_, F_, D_, D_, 0);
  }
  for (int j = 0; j < 2; ++j) {
    p.wqkv[j] = job(da_w_qkv + (size_t)j * D_ * 3072, D_, 3072, 3072, 0);
    p.wdo[j] = job(da_w_o + (size_t)j * D_ * D_, D_, D_, D_, 0);
  }
  p.wret = job(ret_w_qkvg, D_, 6144, 6144, 3);
  p.wreto = job(ret_w_o, 2048, D_, D_, 0);
  for (int i = 0; i < 4; ++i) {
    p.wxq[i] = job(xa_wq + (size_t)i * D_ * D_, D_, D_, D_, 0);
    p.wxkv[i] = job(xa_wkv + (size_t)i * D_ * 2048, D_, 2048, 2048, 0);
    p.wxo[i] = job(xa_wo + (size_t)i * D_ * D_, D_, D_, D_, 0);
  }
  p.wpool = job(pool_w, D_, D_, 256, 4);
  p.njobs = nj; p.tile_start[nj] = tiles;
  p.lam_init[0] = (float)(0.8 - 0.6 * exp(-0.3 * 0.0));
  p.lam_init[1] = (float)(0.8 - 0.6 * exp(-0.3 * 3.0));
  if (!ok) return;
  if (off > ws_size || nj != NJOBS) { if (ok) fprintf(stderr, "workspace too small or job count mismatch: need %zu have %zu, jobs %d\n", off, ws_size, nj); ok = false; return; }
  hipMemsetAsync(p.bar, 0, XCD_BAR_WORDS * 4 + 64 * 256 + 264 * 256, stream);
  void* args[] = {&p};
  hipError_t e = hipLaunchCooperativeKernel((void*)fwd_megakernel, dim3(grid_blocks), dim3(NT), args, 0, stream);
  if (e != hipSuccess) fprintf(stderr, "cooperative launch failed: %s (grid %d)\n", hipGetErrorString(e), grid_blocks);
}
```

```cpp
#include <hip/hip_runtime.h>
#include <hip/hip_cooperative_groups.h>
#include <cstdio>
#include <cstdint>
#include <cmath>
#include <cstring>
namespace cg = cooperative_groups;

#define DI __device__ __forceinline__
typedef unsigned short bf16_t;
typedef short bf16x8 __attribute__((ext_vector_type(8)));
typedef short s16x4 __attribute__((ext_vector_type(4)));
typedef float f32x16 __attribute__((ext_vector_type(16)));
typedef float f32x4 __attribute__((ext_vector_type(4)));
typedef float f32x2 __attribute__((ext_vector_type(2)));
typedef unsigned u32x4 __attribute__((ext_vector_type(4)));
typedef unsigned u32x2 __attribute__((ext_vector_type(2)));
typedef __bf16 bf2_t __attribute__((ext_vector_type(2)));

#ifndef PROBE_DUP
#define PROBE_DUP 0
#endif
constexpr int NT = 512;
constexpr int T_ = 16384, D_ = 1024, S_ = 2048, F_ = 2816;
constexpr int LDS_BYTES = 139264;
constexpr float LN_EPS = 1e-5f;
constexpr float ALPHA = 1.681792830507429f;
constexpr float LOG2E = 1.4426950408889634f;

DI unsigned pack2(float lo, float hi) { f32x2 v = {lo, hi}; bf2_t r = __builtin_convertvector(v, bf2_t); return __builtin_bit_cast(unsigned, r); }
DI bf16_t f2bf(float x) { return (bf16_t)(pack2(x, 0.f) & 0xffffu); }
DI float bf2f(bf16_t v) { return __uint_as_float(((unsigned)v) << 16); }
DI int crow(int i, int hh) { return (i & 3) + 8 * (i >> 2) + 4 * hh; }
DI f32x16 mfma(bf16x8 a, bf16x8 b, f32x16 c) { return __builtin_amdgcn_mfma_f32_32x32x16_bf16(a, b, c, 0, 0, 0); }
DI f32x16 zero16() { f32x16 z; for (int i = 0; i < 16; ++i) z[i] = 0.f; return z; }
DI float ex2(float x) { return __builtin_amdgcn_exp2f(x); }
DI int launder(int x) { asm volatile("" : "+v"(x)); return x; }


typedef unsigned long long u64_t;
DI unsigned ag_ld32(unsigned* p) { return __hip_atomic_load(p, __ATOMIC_RELAXED, __HIP_MEMORY_SCOPE_AGENT); }
DI unsigned ag_add32(unsigned* p, unsigned v) { return __hip_atomic_fetch_add(p, v, __ATOMIC_RELAXED, __HIP_MEMORY_SCOPE_AGENT); }
DI u64_t ag_ld64(u64_t* p) { return __hip_atomic_load(p, __ATOMIC_RELAXED, __HIP_MEMORY_SCOPE_AGENT); }
DI void ag_st64(u64_t* p, u64_t v) { __hip_atomic_store(p, v, __ATOMIC_RELAXED, __HIP_MEMORY_SCOPE_AGENT); }


template <int CTRL> DI float dpp_f(float v) { return __int_as_float(__builtin_amdgcn_update_dpp(0, __float_as_int(v), CTRL, 0xF, 0xF, true)); }
DI float row16_sum(float v) {
  v += dpp_f<0xB1>(v);
  v += dpp_f<0x4E>(v);
  v += dpp_f<0x141>(v);
  v += dpp_f<0x140>(v);
  return v;
}


DI float xhalf_max(float v) { auto r = __builtin_amdgcn_permlane32_swap(__float_as_uint(v), __float_as_uint(v), false, false); return fmaxf(__uint_as_float(r[0]), __uint_as_float(r[1])); }
DI float xhalf_sum(float v) { auto r = __builtin_amdgcn_permlane32_swap(__float_as_uint(v), __float_as_uint(v), false, false); return __uint_as_float(r[0]) + __uint_as_float(r[1]); }

struct TJob { const float* src; bf16_t* dst; int K, N, lds_, ldd, perm, pad; };
constexpr int NJOBS = 35;

struct Params {
  const float *x, *mem; const int* pos;
  const float *ln_g, *ln_b, *lam_q, *lam_k, *subln_g, *pool_b, *pool_scale;
  float* out; unsigned* bar; unsigned* xcnt; unsigned* xrank; u64_t* xstat;
  float* X; bf16_t* Xb; bf16_t* memb;
  float *cosD, *sinD, *cosR, *sinR;
  bf16_t *Kx, *Vxt;
  bf16_t *H, *Q, *Kb, *Vt, *Oa, *Vrt, *G, *Or;
  const bf16_t *win[8], *wout[8], *wqkv[2], *wdo[2], *wpool, *wret, *wreto, *wxq[4], *wxkv[4], *wxo[4];
  float lam_init[2];
  int njobs; int pad;
  int tile_start[NJOBS + 1];
  TJob jobs[NJOBS];
};

template <int BK> DI int swz(int row) { constexpr int CPR = BK / 8; return (row / (16 / CPR)) % CPR; }

template <int ROWS, int BK>
DI void stage_tile(const bf16_t* g, int ld, char* l, int tid) {
  constexpr int CPR = BK / 8, TOT = ROWS * CPR, N = (TOT + NT - 1) / NT;
  const int row0 = tid / CPR, pc = tid % CPR; const int c = pc ^ swz<BK>(row0);
  const unsigned voff = (unsigned)(row0 * ld + c * 8) * 2u;
#pragma unroll
  for (int i = 0; i < N; ++i) {
    if (TOT % NT == 0 || tid + i * NT < TOT) {
      const char* gb = (const char*)g + (size_t)i * (NT / CPR) * ld * 2;
      __builtin_amdgcn_global_load_lds((const unsigned*)(gb + voff), (__attribute__((address_space(3))) unsigned*)(l + i * NT * 16 + __builtin_amdgcn_readfirstlane(tid >> 6) * 1024), 16, 0, 0);
    }
  }
}
DI void wait_vm0() { asm volatile("s_waitcnt vmcnt(0)" ::: "memory"); }

template <int ROWS, int BK>
DI void stage_piece(const bf16_t* g, int ld, char* l, int tid, int i, int wv) {
  constexpr int CPR = BK / 8, TOT = ROWS * CPR;
  const int row0 = tid / CPR, pc = tid % CPR; const int c = pc ^ swz<BK>(row0);
  const unsigned voff = (unsigned)(row0 * ld + c * 8) * 2u;
  if (TOT % NT == 0 || tid + i * NT < TOT) {
    const char* gb = (const char*)g + (size_t)i * (NT / CPR) * ld * 2;
    __builtin_amdgcn_global_load_lds((const unsigned*)(gb + voff), (__attribute__((address_space(3))) unsigned*)(l + i * NT * 16 + wv * 1024), 16, 0, 0);
  }
}

template <int WM, int BK, class Epi, int NTW = 4>
DI void gemm_tile(const bf16_t* __restrict__ A, int lda, const bf16_t* __restrict__ Bt, int ldb, int K, int row0, int col0, char* lds, Epi& epi,
                  bool pre = false, bool has_next = false, int row0n = 0, int col0n = 0) {
  constexpr int WN = 8 / WM, BM = 64 * WM, BN = 32 * NTW * WN, ABYTES = BM * BK * 2, STG = (BM + BN) * BK * 2;
  constexpr int NKK = BK / 16;
  constexpr int NPA = (BM * (BK / 8) + NT - 1) / NT, NPB = (BN * (BK / 8) + NT - 1) / NT, NP = NPA + NPB, PPK = (NP + NKK - 1) / NKK;
  static_assert(2 * STG <= LDS_BYTES, "lds");
  const int tid = launder(threadIdx.x), lane = tid & 63, w = tid >> 6, wm = w % WM, wn = w / WM;
  const int l31 = lane & 31, hh = lane >> 5;
  f32x16 acc[2][NTW];
#pragma unroll
  for (int a = 0; a < 2; ++a)
#pragma unroll
    for (int b = 0; b < NTW; ++b) acc[a][b] = zero16();
  const bf16_t* Ag = A + (size_t)row0 * lda; const bf16_t* Bg = Bt + (size_t)col0 * ldb;
  const int wv = __builtin_amdgcn_readfirstlane(tid >> 6);
  __syncthreads();
  if (!pre) { stage_tile<BM, BK>(Ag, lda, lds, tid); stage_tile<BN, BK>(Bg, ldb, lds + ABYTES, tid); }
  wait_vm0();
  __syncthreads();
  const int nk = K / BK;
  for (int kt = 0; kt < nk; ++kt) {
    char* cur = lds + (kt & 1) * STG; char* nxt = lds + ((kt + 1) & 1) * STG;
    const bool more = kt + 1 < nk;
    const bf16_t* An = Ag + (kt + 1) * BK; const bf16_t* Bn = Bg + (kt + 1) * BK;
    if (!more) epi.pre(row0 + wm * 64, col0 + wn * (32 * NTW), lane, w, lds);
    bf16x8 fa[2][2], fb[2][NTW];
#pragma unroll
    for (int mt = 0; mt < 2; ++mt) { int row = wm * 64 + mt * 32 + l31; fa[0][mt] = *(const bf16x8*)(cur + row * (BK * 2) + ((hh ^ swz<BK>(row)) << 4)); }
#pragma unroll
    for (int nt = 0; nt < NTW; ++nt) { int row = wn * (32 * NTW) + nt * 32 + l31; fb[0][nt] = *(const bf16x8*)(cur + ABYTES + row * (BK * 2) + ((hh ^ swz<BK>(row)) << 4)); }
#pragma unroll
    for (int kk = 0; kk < NKK; ++kk) {
      if (kk + 1 < NKK) {
        const int ch = (kk + 1) * 2 + hh;
#pragma unroll
        for (int mt = 0; mt < 2; ++mt) { int row = wm * 64 + mt * 32 + l31; fa[(kk + 1) & 1][mt] = *(const bf16x8*)(cur + row * (BK * 2) + ((ch ^ swz<BK>(row)) << 4)); }
#pragma unroll
        for (int nt = 0; nt < NTW; ++nt) { int row = wn * (32 * NTW) + nt * 32 + l31; fb[(kk + 1) & 1][nt] = *(const bf16x8*)(cur + ABYTES + row * (BK * 2) + ((ch ^ swz<BK>(row)) << 4)); }
      }
      if (more) {
#pragma unroll
        for (int q = 0; q < PPK; ++q) {
          const int pi = kk * PPK + q;
          if (pi < NPA) stage_piece<BM, BK>(An, lda, nxt, tid, pi, wv);
          else if (pi < NP) stage_piece<BN, BK>(Bn, ldb, nxt + ABYTES, tid, pi - NPA, wv);
        }
      }
      __builtin_amdgcn_s_setprio(1);
#pragma unroll
      for (int mt = 0; mt < 2; ++mt)
#pragma unroll
        for (int nt = 0; nt < NTW; ++nt) acc[mt][nt] = mfma(fa[kk & 1][mt], fb[kk & 1][nt], acc[mt][nt]);
      __builtin_amdgcn_s_setprio(0);
      __builtin_amdgcn_sched_barrier(0);
    }
    wait_vm0();
    __syncthreads();
  }
  if (has_next) { const int tid3 = launder(threadIdx.x); stage_tile<BM, BK>(A + (size_t)row0n * lda, lda, lds, tid3); stage_tile<BN, BK>(Bt + (size_t)col0n * ldb, ldb, lds + ABYTES, tid3); }
  { const int tid2 = launder(threadIdx.x); epi(acc, row0 + (((tid2 >> 6) % WM) * 64), col0 + (((tid2 >> 6) / WM) * (32 * NTW)), tid2 & 63, tid2 >> 6, lds); }
}

template <class Epi>
DI void gemm_tile_p4(const bf16_t* __restrict__ A, int lda, const bf16_t* __restrict__ Bt, int ldb, int K, int row0, int col0, char* lds, Epi& epi) {
  constexpr int BK = 32, BM = 256, BN = 256, ABYTES = BM * BK * 2, STG = (BM + BN) * BK * 2, NS = 4;
  static_assert(NS * STG <= LDS_BYTES, "lds");
  const int tid = launder(threadIdx.x), lane = tid & 63, w = tid >> 6, wm = w & 3, wn = w >> 2;
  const int l31 = lane & 31, hh = lane >> 5;
  f32x16 acc[2][4];
#pragma unroll
  for (int a = 0; a < 2; ++a)
#pragma unroll
    for (int b = 0; b < 4; ++b) acc[a][b] = zero16();
  const bf16_t* Ag = A + (size_t)row0 * lda; const bf16_t* Bg = Bt + (size_t)col0 * ldb;
  const int nk = K / BK;
  __syncthreads();
#pragma unroll
  for (int s = 0; s < NS - 1; ++s) { stage_tile<BM, BK>(Ag + s * BK, lda, lds + s * STG, tid); stage_tile<BN, BK>(Bg + s * BK, ldb, lds + s * STG + ABYTES, tid); }
  int aoff[2][2], boff[4][2];
#pragma unroll
  for (int kk = 0; kk < 2; ++kk) {
    const int ch = kk * 2 + hh;
#pragma unroll
    for (int mt = 0; mt < 2; ++mt) { int row = wm * 64 + mt * 32 + l31; aoff[mt][kk] = row * (BK * 2) + ((ch ^ swz<BK>(row)) << 4); }
#pragma unroll
    for (int nt = 0; nt < 4; ++nt) { int row = wn * 128 + nt * 32 + l31; boff[nt][kk] = ABYTES + row * (BK * 2) + ((ch ^ swz<BK>(row)) << 4); }
  }
  for (int kt = 0; kt < nk; ++kt) {
    if (kt + 2 < nk) asm volatile("s_waitcnt vmcnt(8)" ::: "memory");
    else if (kt + 1 < nk) asm volatile("s_waitcnt vmcnt(4)" ::: "memory");
    else asm volatile("s_waitcnt vmcnt(0)" ::: "memory");
    __builtin_amdgcn_s_barrier();
    asm volatile("" ::: "memory");
    if (kt + NS - 1 < nk) { char* nxt = lds + ((kt + NS - 1) & (NS - 1)) * STG; stage_tile<BM, BK>(Ag + (kt + NS - 1) * BK, lda, nxt, tid); stage_tile<BN, BK>(Bg + (kt + NS - 1) * BK, ldb, nxt + ABYTES, tid); }
    const char* cur = lds + (kt & (NS - 1)) * STG;
#pragma unroll
    for (int kk = 0; kk < 2; ++kk) {
      bf16x8 a[2], b[4];
#pragma unroll
      for (int mt = 0; mt < 2; ++mt) a[mt] = *(const bf16x8*)(cur + aoff[mt][kk]);
#pragma unroll
      for (int nt = 0; nt < 4; ++nt) b[nt] = *(const bf16x8*)(cur + boff[nt][kk]);
#pragma unroll
      for (int mt = 0; mt < 2; ++mt)
#pragma unroll
        for (int nt = 0; nt < 4; ++nt) acc[mt][nt] = mfma(a[mt], b[nt], acc[mt][nt]);
    }
  }
  __syncthreads();
  { const int tid2 = launder(threadIdx.x); epi(acc, row0 + (((tid2 >> 6) & 3) * 64), col0 + (((tid2 >> 6) >> 2) * 128), tid2 & 63, tid2 >> 6, lds); }
}

struct EpiSwiglu {
  DI void pre(int, int, int, int, char*) {}
  bf16_t* H;
  template <int NTW>
  DI void operator()(f32x16 (&acc)[2][NTW], int grow0, int gcol0, int lane, int w, char* lds) {
    const int l31 = lane & 31, hh = lane >> 5;
#pragma unroll
    for (int mt = 0; mt < 2; ++mt)
#pragma unroll
      for (int pr = 0; pr < NTW / 2; ++pr) {
        const int col = (gcol0 / 64 + pr) * 32 + l31;
#pragma unroll
        for (int i = 0; i < 16; ++i) {
          float g = acc[mt][2 * pr][i], u = acc[mt][2 * pr + 1][i];
          float v = g * __builtin_amdgcn_rcpf(1.f + __expf(-g)) * u;
          int row = grow0 + mt * 32 + crow(i, hh);
          H[(size_t)row * F_ + col] = f2bf(v);
        }
      }
  }
};

struct EpiLN {
  DI void pre(int, int, int, int, char*) {}
  const float* Xin; float* Xout; bf16_t* Xb; const float* bias; const float* cscale; const float* g; const float* b; float hs;
  DI void operator()(f32x16 (&acc)[2][4], int grow0, int gcol0, int lane, int w, char* lds) {
    float* red = (float*)lds; float* stat = red + 8 * 64 * 2;
    const int l31 = lane & 31, hh = lane >> 5, tid = w * 64 + lane;
    float bia[4], csc[4];
#pragma unroll
    for (int nt = 0; nt < 4; ++nt) { int c = gcol0 + nt * 32 + l31; bia[nt] = bias ? bias[c] : 0.f; csc[nt] = cscale ? cscale[c] : 1.f; }
    const unsigned base1 = (unsigned)((grow0 + 4 * hh) * D_ + gcol0 + l31);
#pragma unroll
    for (int mt = 0; mt < 2; ++mt) {
#pragma unroll
      for (int i = 0; i < 16; ++i) {
        const unsigned off = base1 + (unsigned)((mt * 32 + (i & 3) + 8 * (i >> 2)) * D_);
        float s1 = 0.f, s2 = 0.f;
#pragma unroll
        for (int nt = 0; nt < 4; ++nt) {
          float v = (acc[mt][nt][i] + bia[nt]) * csc[nt];
          float z = ALPHA * Xin[off + nt * 32] + hs * v;
          acc[mt][nt][i] = z; s1 += z; s2 += z * z;
        }
#pragma unroll
        for (int o = 16; o > 0; o >>= 1) { s1 += __shfl_xor(s1, o); s2 += __shfl_xor(s2, o); }
        if (l31 == 0) { int lr = mt * 32 + crow(i, hh); f32x2 sv = {s1, s2}; *(f32x2*)(red + (w * 64 + lr) * 2) = sv; }
        asm volatile("" ::: "memory");
      }
    }
    __syncthreads();
    if (tid < 64) {
      float s1 = 0.f, s2 = 0.f;
#pragma unroll
      for (int ww = 0; ww < 8; ++ww) { s1 += red[(ww * 64 + tid) * 2]; s2 += red[(ww * 64 + tid) * 2 + 1]; }
      float mean = s1 * (1.f / 1024.f); float var = s2 * (1.f / 1024.f) - mean * mean; var = var < 0.f ? 0.f : var;
      stat[tid * 2] = mean; stat[tid * 2 + 1] = rsqrtf(var + LN_EPS);
    }
    __syncthreads();
    const int lane2 = launder(lane); const int l31b = lane2 & 31, hhb = lane2 >> 5;
    float gg[4], bb[4];
#pragma unroll
    for (int nt = 0; nt < 4; ++nt) { int c = gcol0 + nt * 32 + l31b; gg[nt] = g[c]; bb[nt] = b[c]; }
    const unsigned base2 = (unsigned)((grow0 + 4 * hhb) * D_ + gcol0 + l31b);
#pragma unroll
    for (int mt = 0; mt < 2; ++mt)
#pragma unroll
      for (int i = 0; i < 16; ++i) {
        const int lr = mt * 32 + (i & 3) + 8 * (i >> 2) + 4 * hhb;
        const unsigned off = base2 + (unsigned)((mt * 32 + (i & 3) + 8 * (i >> 2)) * D_);
        const f32x2 st2 = *(const f32x2*)(stat + lr * 2);
#pragma unroll
        for (int nt = 0; nt < 4; ++nt) {
          float v = (acc[mt][nt][i] - st2.x) * st2.y * gg[nt] + bb[nt];
          Xout[off + nt * 32] = v; Xb[off + nt * 32] = f2bf(v);
        }
        asm volatile("" ::: "memory");
      }
  }
};

struct EpiLNX {
  const float* Xin; float* Xout; bf16_t* Xb; const float* bias; const float* cscale; const float* g; const float* b; float hs;
  u64_t* xstat; unsigned* xcnt; unsigned* tmo; unsigned target;
  DI void xpass(int ps, int grow0, int gcol0, int lane, int w, char* lds) const {
    char* xs = lds + (ps & 1) * 65536 + __builtin_amdgcn_readfirstlane(w) * 8192;
    const float* xsrc = Xin + (size_t)(grow0 + (ps >> 1) * 32 + (ps & 1) * 16 + (lane >> 5)) * D_ + gcol0 + (lane & 31) * 4;
#pragma unroll
    for (int pc = 0; pc < 8; ++pc)
      __builtin_amdgcn_global_load_lds((const unsigned*)(xsrc + (size_t)(2 * pc) * D_), (__attribute__((address_space(3))) unsigned*)(xs + pc * 1024), 16, 0, 0);
  }
  DI void pre(int grow0, int gcol0, int lane, int w, char* lds) { xpass(0, grow0, gcol0, lane, w, lds); }
  DI void operator()(f32x16 (&acc)[2][4], int grow0, int gcol0, int lane, int w, char* lds) {
    float* red = (float*)(lds + 131072); float* stat = (float*)lds;
    const int l31 = lane & 31, hh = lane >> 5, tid = w * 64 + lane;
    const int pm = grow0 >> 8, pn = gcol0 >> 8, wn = (gcol0 >> 7) & 1, lrow0 = grow0 & 255;
    float bia[4], csc[4];
#pragma unroll
    for (int nt = 0; nt < 4; ++nt) { int c = gcol0 + nt * 32 + l31; bia[nt] = bias ? bias[c] : 0.f; csc[nt] = cscale ? cscale[c] : 1.f; }
    float* redw = red + ((wn * 2 + ((lane >> 4) & 1)) * 256 + lrow0 + 4 * hh) * 2;
#pragma unroll
    for (int ps = 0; ps < 4; ++ps) {
      const int mt = ps >> 1;
      if (ps + 1 < 4) {
        if (ps >= 1) asm volatile("s_waitcnt lgkmcnt(0)" ::: "memory");
        xpass(ps + 1, grow0, gcol0, lane, w, lds);
        if (ps >= 1) asm volatile("s_waitcnt vmcnt(8)" ::: "memory");
      } else asm volatile("s_waitcnt vmcnt(0)" ::: "memory");
      const char* xs = lds + (ps & 1) * 65536 + w * 8192;
#pragma unroll
      for (int qq = 0; qq < 2; ++qq)
#pragma unroll
        for (int e = 0; e < 4; ++e) {
          const int i = 4 * (2 * (ps & 1) + qq) + e;
          const float* xr = (const float*)(xs + (8 * qq + 4 * hh + e) * 512) + l31;
          float s1 = 0.f, s2 = 0.f;
#pragma unroll
          for (int nt = 0; nt < 4; ++nt) {
            float v = (acc[mt][nt][i] + bia[nt]) * csc[nt];
            float z = ALPHA * xr[nt * 32] + hs * v;
            acc[mt][nt][i] = z; s1 += z; s2 += z * z;
          }
          s1 = row16_sum(s1); s2 = row16_sum(s2);
          if ((lane & 15) == 0) { f32x2 sv = {s1, s2}; *(f32x2*)(redw + (mt * 32 + (i & 3) + 8 * (i >> 2)) * 2) = sv; }
        }
    }
    __syncthreads();
    u64_t* myslots = xstat + ((size_t)pm * 256) * 4;
    if (tid < 256) {
      float s1 = (red[tid * 2] + red[(256 + tid) * 2]) + (red[(512 + tid) * 2] + red[(768 + tid) * 2]);
      float s2 = (red[tid * 2 + 1] + red[(256 + tid) * 2 + 1]) + (red[(512 + tid) * 2 + 1] + red[(768 + tid) * 2 + 1]);
      ag_st64(myslots + tid * 4 + pn, ((u64_t)__float_as_uint(s2) << 32) | (u64_t)__float_as_uint(s1));
    }
    asm volatile("s_waitcnt vmcnt(0)" ::: "memory");
    __syncthreads();
    if (tid == 0) {
      unsigned* c = xcnt + pm * 64;
      ag_add32(c, 1u);
      unsigned sp = 0;
      while (ag_ld32(c) < target) {
        __builtin_amdgcn_s_sleep(1);
        if ((++sp & 255u) == 0u) { if (ag_ld32(tmo)) break; if (sp > (1u << 20)) { atomicAdd(tmo, 1u); break; } }
      }
    }
    __syncthreads();
    if (tid < 256) {
      float s1 = 0.f, s2 = 0.f;
#pragma unroll
      for (int q = 0; q < 4; ++q) { u64_t v = ag_ld64(myslots + tid * 4 + q); s1 += __uint_as_float((unsigned)v); s2 += __uint_as_float((unsigned)(v >> 32)); }
      float mean = s1 * (1.f / 1024.f); float var = s2 * (1.f / 1024.f) - mean * mean; var = var < 0.f ? 0.f : var;
      f32x2 sv = {mean, rsqrtf(var + LN_EPS)}; *(f32x2*)(stat + tid * 2) = sv;
    }
    __syncthreads();
    const int lane2 = launder(lane); const int l31b = lane2 & 31, hhb = lane2 >> 5;
    float gg[4], bb[4];
#pragma unroll
    for (int nt = 0; nt < 4; ++nt) { int c = gcol0 + nt * 32 + l31b; gg[nt] = g[c]; bb[nt] = b[c]; }
    const unsigned base2 = (unsigned)((grow0 + 4 * hhb) * D_ + gcol0 + l31b);
#pragma unroll
    for (int mt = 0; mt < 2; ++mt)
#pragma unroll
      for (int i = 0; i < 16; ++i) {
        const int lr = lrow0 + mt * 32 + (i & 3) + 8 * (i >> 2) + 4 * hhb;
        const unsigned off = base2 + (unsigned)((mt * 32 + (i & 3) + 8 * (i >> 2)) * D_);
        const f32x2 st2 = *(const f32x2*)(stat + lr * 2);
#pragma unroll
        for (int nt = 0; nt < 4; ++nt) {
          float v = (acc[mt][nt][i] - st2.x) * st2.y * gg[nt] + bb[nt];
          Xout[off + nt * 32] = v; Xb[off + nt * 32] = f2bf(v);
        }
        asm volatile("" ::: "memory");
      }
  }
};

DI void store_tr(bf16_t* dstrow, int tok0, const f32x16& v, int hh, float mul) {
#pragma unroll
  for (int qd = 0; qd < 4; ++qd) {
    u32x2 p; p.x = pack2(v[4 * qd] * mul, v[4 * qd + 1] * mul); p.y = pack2(v[4 * qd + 2] * mul, v[4 * qd + 3] * mul);
    *(u32x2*)(dstrow + tok0 + 8 * qd + 4 * hh) = p;
  }
}

DI char* tr_stage(char* lds, int w) { return lds + 65536 + w * 8192; }
DI void tr_put(char* stg, int erow, const f32x16& v, int hh, float mul) {
#pragma unroll
  for (int qd = 0; qd < 4; ++qd) {
    u32x2 pk; pk.x = pack2(v[4 * qd] * mul, v[4 * qd + 1] * mul); pk.y = pack2(v[4 * qd + 2] * mul, v[4 * qd + 3] * mul);
    *(u32x2*)(stg + erow * 64 + (8 * qd + 4 * hh) * 2) = pk;
  }
}
template <int R>
DI void tr_flush(const char* stg, int row0, bf16_t* g, size_t grs, int lane) {
  const int r0 = lane >> 2, ch = lane & 3;
#pragma unroll
  for (int it = 0; it < R / 16; ++it) {
    const int r = it * 16 + r0;
    u32x4 v = *(const u32x4*)(stg + (row0 + r) * 64 + ch * 16);
    *(u32x4*)((char*)(g + (size_t)r * grs) + ch * 16) = v;
  }
}

struct EpiDAqkv {
  DI void pre(int, int, int, int, char*) {}
  bf16_t *Q, *K, *Vt; const float *cs, *sn;
  DI void operator()(f32x16 (&acc)[2][4], int grow0, int gcol0, int lane, int w, char* lds) {
    const int l31 = lane & 31, hh = lane >> 5;
    const int part = gcol0 >> 10, cin = gcol0 & 1023;
    if (part < 2) {
      bf16_t* dst = part == 0 ? Q : K;
#pragma unroll
      for (int mt = 0; mt < 2; ++mt)
#pragma unroll
        for (int pr = 0; pr < 2; ++pr)
#pragma unroll
          for (int i = 0; i < 16; ++i) {
            int row = grow0 + mt * 32 + crow(i, hh);
            float c = cs[row * 32 + l31], s = sn[row * 32 + l31];
            float x1 = acc[mt][2 * pr][i], x2 = acc[mt][2 * pr + 1][i];
            int col = cin + pr * 64 + l31;
            dst[(size_t)row * D_ + col] = f2bf(x1 * c - x2 * s);
            dst[(size_t)row * D_ + col + 32] = f2bf(x2 * c + x1 * s);
          }
    } else {
      const int b = grow0 >> 11, s0 = grow0 & 2047, h = cin >> 7;
      char* stg = tr_stage(lds, w);
#pragma unroll
      for (int mt = 0; mt < 2; ++mt) {
#pragma unroll
        for (int nt = 0; nt < 4; ++nt) tr_put(stg, nt * 32 + l31, acc[mt][nt], hh, 1.f);
        tr_flush<128>(stg, 0, Vt + ((size_t)(b * 8 + h) * 128) * S_ + s0 + mt * 32, S_, lane);
      }
    }
  }
};

struct EpiRETqkvg {
  DI void pre(int, int, int, int, char*) {}
  bf16_t *Q, *K, *Kdt, *Vrt, *G; const float *cs, *sn;
  DI void operator()(f32x16 (&acc)[2][4], int grow0, int gcol0, int lane, int w, char* lds) {
    const int l31 = lane & 31, hh = lane >> 5;
    const int b = grow0 >> 11, s0 = grow0 & 2047;
    if (gcol0 < 2048) {
      const int part = gcol0 >> 10, cin = gcol0 & 1023, h = cin >> 8, p0 = (cin & 255) >> 6;
      const float lg = logf(1.f - ex2(-5.f - (float)h));
      bf16_t* dst = part == 0 ? Q : K;
      const float mul = part == 0 ? 1.f : 0.0625f;
#pragma unroll
      for (int pr = 0; pr < 2; ++pr) {
        const int d = 32 * (p0 + pr) + l31;
        bf16_t* r1 = Kdt + ((size_t)(b * 4 + h) * 256 + d) * S_ + s0;
#pragma unroll
        for (int mt = 0; mt < 2; ++mt) {
          float c16[16], s16[16];
#pragma unroll
          for (int i = 0; i < 16; ++i) { const unsigned to = (unsigned)((grow0 + mt * 32 + crow(i, hh)) * 128 + d); c16[i] = cs[to]; s16[i] = sn[to]; }
#pragma unroll
          for (int qd = 0; qd < 4; ++qd) {
            float o1[4], o2[4];
#pragma unroll
            for (int e = 0; e < 4; ++e) {
              const int i = 4 * qd + e;
              const int row = grow0 + mt * 32 + 8 * qd + 4 * hh + e;
              float c = c16[i], s = s16[i];
              float x1 = acc[mt][2 * pr][i], x2 = acc[mt][2 * pr + 1][i];
              o1[e] = (x1 * c - x2 * s) * mul; o2[e] = (x2 * c + x1 * s) * mul;
              const unsigned oo = (unsigned)(row * D_ + h * 256 + d);
              dst[oo] = f2bf(o1[e]); dst[oo + 128] = f2bf(o2[e]);
            }
            if (part == 1) {
              const int rl = (mt * 32 + 8 * qd + 4 * hh) & 127;
              const int rb = (grow0 & 127) + rl;
#pragma unroll
              for (int e = 0; e < 4; ++e) { float kd = __expf((float)(127 - (rb + e)) * lg); o1[e] *= kd; o2[e] *= kd; }
              u32x2 p1, p2; p1.x = pack2(o1[0], o1[1]); p1.y = pack2(o1[2], o1[3]); p2.x = pack2(o2[0], o2[1]); p2.y = pack2(o2[2], o2[3]);
              *(u32x2*)(r1 + mt * 32 + 8 * qd + 4 * hh) = p1;
              *(u32x2*)(r1 + (size_t)128 * S_ + mt * 32 + 8 * qd + 4 * hh) = p2;
            }
          }
          asm volatile("" ::: "memory");
        }
      }
    } else if (gcol0 < 4096) {
      const int cin = gcol0 - 2048, h = cin >> 9;
      char* stg = tr_stage(lds, w);
#pragma unroll
      for (int mt = 0; mt < 2; ++mt) {
#pragma unroll
        for (int nt = 0; nt < 4; ++nt) tr_put(stg, nt * 32 + l31, acc[mt][nt], hh, 1.f);
        tr_flush<128>(stg, 0, Vrt + ((size_t)(b * 4 + h) * 512 + (cin & 511)) * S_ + s0 + mt * 32, S_, lane);
      }
    } else {
      const int cin = gcol0 - 4096;
#pragma unroll
      for (int mt = 0; mt < 2; ++mt)
#pragma unroll
        for (int nt = 0; nt < 4; ++nt)
#pragma unroll
          for (int i = 0; i < 16; ++i) { int row = grow0 + mt * 32 + crow(i, hh); G[(size_t)row * 2048 + cin + nt * 32 + l31] = f2bf(acc[mt][nt][i]); }
    }
  }
};

struct EpiPlain {
  DI void pre(int, int, int, int, char*) {}
  bf16_t* dst; float mul;
  DI void operator()(f32x16 (&acc)[2][4], int grow0, int gcol0, int lane, int w, char* lds) {
    const int l31 = lane & 31, hh = lane >> 5;
#pragma unroll
    for (int mt = 0; mt < 2; ++mt)
#pragma unroll
      for (int nt = 0; nt < 4; ++nt)
#pragma unroll
        for (int i = 0; i < 16; ++i) { int row = grow0 + mt * 32 + crow(i, hh); dst[(size_t)row * D_ + gcol0 + nt * 32 + l31] = f2bf(acc[mt][nt][i] * mul); }
  }
};

struct EpiXkv {
  DI void pre(int, int, int, int, char*) {}
  bf16_t *Kx, *Vxt;
  DI void operator()(f32x16 (&acc)[2][4], int grow0, int gcol0, int lane, int w, char* lds) {
    const int l31 = lane & 31, hh = lane >> 5;
    if (gcol0 < 1024) {
#pragma unroll
      for (int mt = 0; mt < 2; ++mt)
#pragma unroll
        for (int nt = 0; nt < 4; ++nt)
#pragma unroll
          for (int i = 0; i < 16; ++i) { int row = grow0 + mt * 32 + crow(i, hh); Kx[(size_t)row * D_ + gcol0 + nt * 32 + l31] = f2bf(acc[mt][nt][i]); }
    } else {
      const int cin = gcol0 - 1024, h = cin >> 8, b = grow0 >> 8, m0 = grow0 & 255;
      char* stg = tr_stage(lds, w);
#pragma unroll
      for (int mt = 0; mt < 2; ++mt) {
#pragma unroll
        for (int nt = 0; nt < 4; ++nt) tr_put(stg, nt * 32 + l31, acc[mt][nt], hh, 1.f);
        tr_flush<128>(stg, 0, Vxt + ((size_t)(b * 4 + h) * 256 + (cin & 255)) * 256 + m0 + mt * 32, 256, lane);
      }
    }
  }
};

template <class Epi>
DI void gemm_phase256(const bf16_t* A, int lda, const bf16_t* Bt, int K, int nN, char* lds, Epi& epi, int vb) {
  const int ntiles = 64 * nN;
  bool pre = false;
  for (int t = vb; t < ntiles; t += gridDim.x) {
    const int x = t & 7, L = t >> 3; const int pm = 8 * x + (L & 7), pn = L >> 3;
    const int t2 = t + gridDim.x; const bool hn = t2 < ntiles;
    const int x2 = t2 & 7, L2 = t2 >> 3; const int pm2 = 8 * x2 + (L2 & 7), pn2 = L2 >> 3;
    gemm_tile<4, 64>(A, lda, Bt, K, K, pm * 256, pn * 256, lds, epi, pre, hn, pm2 * 256, pn2 * 256);
    pre = hn;
  }
}
template <class Epi>
DI void gemm_phaseLNX(const bf16_t* A, int K, const bf16_t* Bt, char* lds, Epi& epi, int vb, bool blockdiag = false) {
  const int t = vb; const int x = t & 7, L = t >> 3; const int pm = 8 * x + (L & 7), pn = L >> 3;
  if (blockdiag) gemm_tile<4, 64>(A + pn * 256, K, Bt + pn * 256, K, 256, pm * 256, pn * 256, lds, epi);
  else gemm_tile<4, 64>(A, K, Bt, K, K, pm * 256, pn * 256, lds, epi);
}
template <class Epi>
DI void gemm_phaseLN(const bf16_t* A, int K, const bf16_t* Bt, char* lds, Epi& epi) {
  for (int t = blockIdx.x; t < 256; t += gridDim.x) gemm_tile<1, 32>(A, K, Bt, K, K, t * 64, 0, lds, epi);
}

DI int src_col(int perm, int n) {
  if (perm == 1) { int p = n >> 6, r = n & 63; return r < 32 ? 32 * p + r : 2816 + 32 * p + (r - 32); }
  if (perm == 3) {
    if (n >= 2048) return n;
    int part = n >> 10, h = (n & 1023) >> 8, n2 = n & 255, p = n2 >> 6, r = n2 & 63;
    int d = r < 32 ? 32 * p + r : 128 + 32 * p + (r - 32);
    return part * 1024 + h * 256 + d;
  }
  return n;
}

DI void phase_prologue(const Params& p, char* lds) {
  const int tid = launder(threadIdx.x);
  float* tile = (float*)lds;
  const int total = p.tile_start[p.njobs];
  int j = 0;
  for (int t = blockIdx.x; t < total; t += gridDim.x) {
    while (j + 1 < p.njobs && t >= p.tile_start[j + 1]) ++j;
    const TJob& jb = p.jobs[j];
    const int lt = t - p.tile_start[j];
    const int nkt = jb.K >> 7;
    const int k0 = (lt % nkt) << 7, n0 = (lt / nkt) << 7;
    __syncthreads();
    {
      const int nl = tid & 127, kb = tid >> 7;
      const int n = n0 + nl;
      if (jb.perm == 4) {
        const int g = n >> 8, gk = k0 >> 8;
#pragma unroll 8
        for (int i = 0; i < 32; ++i) { int kl = kb + 4 * i; int k = k0 + kl; tile[kl * 129 + nl] = (g == gk) ? jb.src[(size_t)g * 65536 + (size_t)(k & 255) * 256 + (n & 255)] : 0.f; }
      } else {
        const int sc = src_col(jb.perm, n);
        const float* sp = jb.src + (size_t)k0 * jb.lds_ + sc;
#pragma unroll 16
        for (int i = 0; i < 32; ++i) { int kl = kb + 4 * i; tile[kl * 129 + nl] = sp[(size_t)kl * jb.lds_]; }
      }
    }
    __syncthreads();
    {
      const int kl = tid & 127, nb = tid >> 7;
#pragma unroll 16
      for (int i = 0; i < 32; ++i) { int nl = nb + 4 * i; jb.dst[(size_t)(n0 + nl) * jb.ldd + k0 + kl] = f2bf(tile[kl * 129 + nl]); }
    }
  }
  const size_t gtid = (size_t)blockIdx.x * NT + tid, gsz = (size_t)gridDim.x * NT;
  for (size_t i = gtid; i < (size_t)T_ * D_ / 4; i += gsz) {
    f32x4 v = ((const f32x4*)p.x)[i];
    u32x2 o; o.x = pack2(v[0], v[1]); o.y = pack2(v[2], v[3]); ((u32x2*)p.Xb)[i] = o;
  }
  for (size_t i = gtid; i < (size_t)2048 * D_ / 4; i += gsz) {
    f32x4 v = ((const f32x4*)p.mem)[i];
    u32x2 o; o.x = pack2(v[0], v[1]); o.y = pack2(v[2], v[3]); ((u32x2*)p.memb)[i] = o;
  }
  const double TWO_PI = 6.283185307179586476925286766559;
  const double L2T = 13.287712379549449391481277717958;
  for (size_t i = gtid; i < (size_t)T_ * 32; i += gsz) {
    int t = (int)(i >> 5), k = (int)(i & 31);
    double inv = exp2(-(double)k * (1.0 / 32.0) * L2T);
    double ang = (double)p.pos[t] * inv; ang -= TWO_PI * rint(ang * (1.0 / TWO_PI));
    float a = (float)ang; p.cosD[i] = cosf(a); p.sinD[i] = sinf(a);
  }
  for (size_t i = gtid; i < (size_t)T_ * 128; i += gsz) {
    int t = (int)(i >> 7), k = (int)(i & 127);
    double inv = exp2(-(double)k * (1.0 / 127.0) * L2T);
    double ang = (double)p.pos[t] * inv; ang -= TWO_PI * rint(ang * (1.0 / TWO_PI));
    float a = (float)ang; p.cosR[i] = cosf(a); p.sinR[i] = sinf(a);
  }
}

template <int VSTR, bool DEFER = false>
DI void softmax_pv(f32x16 (&st)[2], float& m, float& l, f32x16 (&o)[4], const char* vt, int erow0, int lane) {
  const int l31 = lane & 31, hh = lane >> 5;
  float mx = -1e30f;
#pragma unroll
  for (int mt = 0; mt < 2; ++mt)
#pragma unroll
    for (int i = 0; i < 16; ++i) mx = fmaxf(mx, st[mt][i]);
  mx = xhalf_max(mx);
  if (DEFER) {
    constexpr float THR = 6.0f;
    if (__any(mx > m + THR)) {
      const float mn = fmaxf(m, mx);
      const float al = ex2(m - mn);
      m = mn;
      l *= al;
#pragma unroll
      for (int et = 0; et < 4; ++et)
#pragma unroll
        for (int i = 0; i < 16; ++i) o[et][i] *= al;
    }
    float ps = 0.f;
#pragma unroll
    for (int mt = 0; mt < 2; ++mt)
#pragma unroll
      for (int i = 0; i < 16; ++i) { float pv = ex2(st[mt][i] - m); st[mt][i] = pv; ps += pv; }
    l += ps;
  } else {
    const float mn = fmaxf(m, mx);
    const float al = ex2(m - mn);
    m = mn;
    float ps = 0.f;
#pragma unroll
    for (int mt = 0; mt < 2; ++mt)
#pragma unroll
      for (int i = 0; i < 16; ++i) { float pv = ex2(st[mt][i] - mn); st[mt][i] = pv; ps += pv; }
    l = l * al + ps;
#pragma unroll
    for (int et = 0; et < 4; ++et)
#pragma unroll
      for (int i = 0; i < 16; ++i) o[et][i] *= al;
  }
#pragma unroll
  for (int mt = 0; mt < 2; ++mt)
#pragma unroll
    for (int s = 0; s < 2; ++s) {
      u32x4 pb; pb.x = pack2(st[mt][8 * s], st[mt][8 * s + 1]); pb.y = pack2(st[mt][8 * s + 2], st[mt][8 * s + 3]);
      pb.z = pack2(st[mt][8 * s + 4], st[mt][8 * s + 5]); pb.w = pack2(st[mt][8 * s + 6], st[mt][8 * s + 7]);
      const bf16x8 bfrag = __builtin_bit_cast(bf16x8, pb);
      const int kb = mt * 32 + 16 * s + 4 * hh;
#pragma unroll
      for (int et = 0; et < 4; ++et) {
        const char* rp = vt + (erow0 + et * 32 + l31) * VSTR + kb * 2;
        s16x4 lo = *(const s16x4*)rp, hi = *(const s16x4*)(rp + 16);
        bf16x8 afrag = __builtin_shufflevector(lo, hi, 0, 1, 2, 3, 4, 5, 6, 7);
        o[et] = mfma(afrag, bfrag, o[et]);
      }
    }
}


DI f32x16 dot16_lds(const char* img, int row, int hh, const bf16x8 (&qf)[16], f32x16 acc) {
  const char* rp = img + row * 512; const int r15 = row & 15;
  bf16x8 a[2][4];
#pragma unroll
  for (int q = 0; q < 4; ++q) a[0][q] = *(const bf16x8*)(rp + ((((q * 2) + hh) ^ r15) << 4));
#pragma unroll
  for (int g = 0; g < 4; ++g) {
    if (g + 1 < 4) {
#pragma unroll
      for (int q = 0; q < 4; ++q) a[(g + 1) & 1][q] = *(const bf16x8*)(rp + (((((g + 1) * 4 + q) * 2 + hh) ^ r15) << 4));
    }
#pragma unroll
    for (int q = 0; q < 4; ++q) acc = mfma(a[g & 1][q], qf[g * 4 + q], acc);
    __builtin_amdgcn_sched_barrier(0);
  }
  return acc;
}
DI void phase_da_attn(const Params& p, int j, char* lds) {
  const int tid = launder(threadIdx.x), lane = tid & 63, w = tid >> 6, l31 = lane & 31, hh = lane >> 5;
  const int c = w & 1, qg = w >> 1;
  constexpr int KVB = 33792;
  float* cmb = (float*)(lds + 2 * KVB);
  float lam;
  {
    const float* lq = p.lam_q + j * 128; const float* lk = p.lam_k + j * 128;
    float v0 = lq[lane] * lk[lane], v1 = lq[64 + lane] * lk[64 + lane];
#pragma unroll
    for (int o = 32; o > 0; o >>= 1) { v0 += __shfl_xor(v0, o); v1 += __shfl_xor(v1, o); }
    lam = __expf(v0) - __expf(v1) + p.lam_init[j];
  }
  const float li = p.lam_init[j];
  const float sc = 0.125f * LOG2E;
  const bf16_t* Q = p.Q; const bf16_t* K = p.Kb; const bf16_t* Vt = p.Vt;
  for (int it = blockIdx.x; it < 1024; it += gridDim.x) {
    const int jj = it & 255, kr = it >> 8, g = jj >> 6, bh = jj & 63;
    const int qb = kr == 0 ? 15 - g : kr == 1 ? 8 + g : kr == 2 ? 7 - g : g;
    const int b = bh >> 3, h = bh & 7;
    const int q0 = qb * 128 + qg * 32;
    const int myq = q0 + l31;
    const size_t tokb = (size_t)b * S_;
    bf16x8 qf[4];
#pragma unroll
    for (int kk = 0; kk < 4; ++kk) qf[kk] = *(const bf16x8*)(Q + (tokb + myq) * D_ + h * 128 + c * 64 + kk * 16 + 8 * hh);
    f32x16 o[4];
#pragma unroll
    for (int et = 0; et < 4; ++et) o[et] = zero16();
    float m = -1e30f, l = 0.f;
    const int nkt = 2 * (qb + 1);
    u32x4 rk[2], rv[2];
    auto gload = [&](int kt) {
#pragma unroll
      for (int i = 0; i < 2; ++i) {
        int idx = tid + i * NT;
        { int row = idx >> 4, ch = idx & 15; rk[i] = *(const u32x4*)(K + (tokb + kt * 64 + row) * D_ + h * 128 + ch * 8); }
        { int row = idx >> 3, ch = idx & 7; rv[i] = *(const u32x4*)(Vt + ((size_t)(b * 8 + h) * 128 + row) * S_ + kt * 64 + ch * 8); }
      }
    };
    auto lwrite = [&](int buf) {
      char* kt_w = lds + buf * KVB; char* vt_w = kt_w + 16384;
#pragma unroll
      for (int i = 0; i < 2; ++i) {
        int idx = tid + i * NT;
        { int row = idx >> 4, ch = idx & 15; *(u32x4*)(kt_w + row * 256 + ((ch ^ (row & 15)) << 4)) = rk[i]; }
        { int row = idx >> 3, ch = idx & 7; char* d = vt_w + row * 136 + ch * 16; u32x2 a = {rv[i].x, rv[i].y}, bq = {rv[i].z, rv[i].w}; *(u32x2*)d = a; *(u32x2*)(d + 8) = bq; }
      }
    };
    __syncthreads();
    gload(0); lwrite(0);
    if (nkt > 1) gload(1);
    __syncthreads();
    for (int kt = 0; kt < nkt; ++kt) {
      if (kt + 1 < nkt) lwrite((kt + 1) & 1);
      if (kt + 2 < nkt) gload(kt + 2);
      const char* kt_l = lds + (kt & 1) * KVB; const char* vt_l = kt_l + 16384;
      if (kt * 64 <= q0 + 31) {
        f32x16 st[2];
#pragma unroll
        for (int mt = 0; mt < 2; ++mt) {
          st[mt] = zero16();
          const int row = mt * 32 + l31;
#pragma unroll
          for (int kk = 0; kk < 4; ++kk) {
            int ch = c * 8 + kk * 2 + hh;
            bf16x8 a = *(const bf16x8*)(kt_l + row * 256 + ((ch ^ (row & 15)) << 4));
            st[mt] = mfma(a, qf[kk], st[mt]);
          }
        }
        const bool diag = kt * 64 + 63 > q0;
#pragma unroll
        for (int mt = 0; mt < 2; ++mt)
#pragma unroll
          for (int i = 0; i < 16; ++i) {
            float s = st[mt][i] * sc;
            if (diag) { int key = kt * 64 + mt * 32 + crow(i, hh); if (key > myq) s = -1e30f; }
            st[mt][i] = s;
          }
        softmax_pv<136, true>(st, m, l, o, vt_l, 0, lane);
      }
      __syncthreads();
    }
    l = xhalf_sum(l);
    const float inv = 1.f / l;
    if (c == 1) {
#pragma unroll
      for (int et = 0; et < 4; ++et)
#pragma unroll
        for (int i = 0; i < 16; ++i) cmb[(qg * 128 + et * 32 + crow(i, hh)) * 32 + l31] = o[et][i] * inv;
    }
    __syncthreads();
    if (c == 0) {
      float ss = 0.f;
#pragma unroll
      for (int et = 0; et < 4; ++et)
#pragma unroll
        for (int i = 0; i < 16; ++i) { float v = o[et][i] * inv - lam * cmb[(qg * 128 + et * 32 + crow(i, hh)) * 32 + l31]; o[et][i] = v; ss += v * v; }
      ss = xhalf_sum(ss);
      const float r = rsqrtf(ss * (1.f / 128.f) + LN_EPS) * (1.f - li);
      bf16_t* orow = p.Oa + (tokb + myq) * D_ + h * 128;
      const float* sg = p.subln_g + j * 128;
#pragma unroll
      for (int et = 0; et < 4; ++et)
#pragma unroll
        for (int qd = 0; qd < 4; ++qd) {
          int e = et * 32 + 8 * qd + 4 * hh;
          f32x4 gv = *(const f32x4*)(sg + e);
          u32x2 pk; pk.x = pack2(o[et][4 * qd] * r * gv[0], o[et][4 * qd + 1] * r * gv[1]); pk.y = pack2(o[et][4 * qd + 2] * r * gv[2], o[et][4 * qd + 3] * r * gv[3]);
          *(u32x2*)(orow + e) = pk;
        }
    }
  }
}

DI void phase_xa_attn(const Params& p, int layer, char* lds) {
  const int tid = launder(threadIdx.x), lane = tid & 63, w = tid >> 6, l31 = lane & 31, hh = lane >> 5;
  const int eh = w & 1, qg = w >> 1;
  const bf16_t* Q = p.Q; const bf16_t* K = p.Kx + (size_t)layer * 2048 * D_; const bf16_t* Vt = p.Vxt + (size_t)layer * 32 * 256 * 256;
  for (int it = blockIdx.x; it < 512; it += gridDim.x) {
    const int h = it & 3, qt = it >> 2, b = qt >> 4;
    const size_t tok = (size_t)qt * 128 + qg * 32 + l31;
    bf16x8 qf[16];
#pragma unroll
    for (int kk = 0; kk < 16; ++kk) qf[kk] = *(const bf16x8*)(Q + tok * D_ + h * 256 + kk * 16 + 8 * hh);
    f32x16 o[4];
#pragma unroll
    for (int et = 0; et < 4; ++et) o[et] = zero16();
    float m = -1e30f, l = 0.f;
    u32x4 rv[4];
    auto kdma = [&](int kt) {
      char* kb = lds + (kt & 1) * 32768;
#pragma unroll 1
      for (int i = 0; i < 4; ++i) {
        const int pc = __builtin_amdgcn_readfirstlane(w) * 4 + i; const int row = 2 * pc + (lane >> 5); const int cc = (lane & 31) ^ (row & 15);
        __builtin_amdgcn_global_load_lds((const unsigned*)(K + ((size_t)b * 256 + kt * 64 + row) * D_ + h * 256 + cc * 8), (__attribute__((address_space(3))) unsigned*)(kb + pc * 1024), 16, 0, 0);
      }
    };
    auto vload = [&](int kt) {
#pragma unroll
      for (int i = 0; i < 4; ++i) { int idx = tid + i * NT; int row = idx >> 3, ch = idx & 7; rv[i] = *(const u32x4*)(Vt + ((size_t)(b * 4 + h) * 256 + row) * 256 + kt * 64 + ch * 8); }
    };
    auto vwrite = [&](int kt) {
      char* vb_ = lds + 65536 + (kt & 1) * 34816;
#pragma unroll
      for (int i = 0; i < 4; ++i) { int idx = tid + i * NT; int row = idx >> 3, ch = idx & 7; char* d = vb_ + row * 136 + ch * 16; u32x2 a = {rv[i].x, rv[i].y}, bq = {rv[i].z, rv[i].w}; *(u32x2*)d = a; *(u32x2*)(d + 8) = bq; }
    };
    __syncthreads();
    kdma(0); vload(0); vwrite(0);
    wait_vm0();
    __syncthreads();
    for (int kt = 0; kt < 4; ++kt) {
      if (kt + 1 < 4) kdma(kt + 1);
      const char* kt_l = lds + (kt & 1) * 32768; const char* vt_l = lds + 65536 + (kt & 1) * 34816;
      f32x16 st[2];
      const int l31k = launder(l31);
#pragma unroll
      for (int mt = 0; mt < 2; ++mt) {
        st[mt] = dot16_lds(kt_l, mt * 32 + l31k, hh, qf, zero16());
      }
#pragma unroll
      for (int mt = 0; mt < 2; ++mt)
#pragma unroll
        for (int i = 0; i < 16; ++i) st[mt][i] *= LOG2E;
      softmax_pv<136>(st, m, l, o, vt_l, eh * 128, lane);
      if (kt + 1 < 4) { vload(kt + 1); vwrite(kt + 1); }
      wait_vm0();
      __syncthreads();
    }
    l = xhalf_sum(l);
    const float inv = 1.f / l;
    char* stg = lds + w * 8704;
#pragma unroll
    for (int et = 0; et < 4; ++et)
#pragma unroll
      for (int qd = 0; qd < 4; ++qd) {
        int e = et * 32 + 8 * qd + 4 * hh;
        u32x2 pk; pk.x = pack2(o[et][4 * qd] * inv, o[et][4 * qd + 1] * inv); pk.y = pack2(o[et][4 * qd + 2] * inv, o[et][4 * qd + 3] * inv);
        *(u32x2*)(stg + l31 * 272 + e * 2) = pk;
      }
    {
      bf16_t* obase = p.Oa + ((size_t)qt * 128 + qg * 32) * D_ + h * 256 + eh * 128;
      const int r0 = lane >> 4, ch = lane & 15;
#pragma unroll 2
      for (int it = 0; it < 8; ++it) {
        const int r = it * 4 + r0;
        u32x4 v = *(const u32x4*)(stg + r * 272 + ch * 16);
        *(u32x4*)(obase + (size_t)r * D_ + ch * 8) = v;
      }
    }
  }
}

DI void phase_ret(const Params& p, char* lds) {
  const int tid = launder(threadIdx.x), lane = tid & 63, w = tid >> 6, l31 = lane & 31, hh = lane >> 5;
  char* k_l = lds;
  char* v_l = lds + 65536;
  char* r_l = lds + 65536 + 16896;
  const int et = w & 1, itl = w >> 1;
  for (int it = blockIdx.x; it < 256; it += gridDim.x) {
    const int xq = it & 7, rq = it >> 3;
    const int sl = rq & 7, bh = xq * 4 + (rq >> 3), b = bh >> 2, h = bh & 3;
    const float lg = logf(1.f - ex2(-5.f - (float)h));
    const float lg2 = lg * LOG2E;
    const float cd = ex2(128.f * lg2);
    const size_t tokb = (size_t)b * S_;
    f32x16 R[2]; R[0] = zero16(); R[1] = zero16();
    const int myi = itl * 32 + l31;
    const float qd = ex2((float)(myi + 1) * lg2);
    for (int ck = 0; ck < 16; ++ck) {
      const int s0 = ck * 128;
      const int l31k = launder(l31), hhk = launder(hh);
      __syncthreads();
#pragma unroll 1
      for (int i = 0; i < 8; ++i) {
        const int pc = __builtin_amdgcn_readfirstlane(w) * 8 + i; const int row = 2 * pc + (lane >> 5); const int c = (lane & 31) ^ (row & 15);
        __builtin_amdgcn_global_load_lds((const unsigned*)(p.Kb + (tokb + s0 + row) * D_ + h * 256 + c * 8), (__attribute__((address_space(3))) unsigned*)(k_l + pc * 1024), 16, 0, 0);
      }
#pragma unroll
      for (int i = 0; i < 2; ++i) {
        int idx = tid + i * NT; int row = idx >> 4, ch = idx & 15;
        u32x4 v = *(const u32x4*)(p.Vrt + ((size_t)bh * 512 + sl * 64 + row) * S_ + s0 + ch * 8);
        char* d = v_l + row * 264 + ch * 16; u32x2 a = {v.x, v.y}, bq = {v.z, v.w}; *(u32x2*)d = a; *(u32x2*)(d + 8) = bq;
      }
      bf16x8 qf[16];
#pragma unroll
      for (int kk = 0; kk < 16; ++kk) qf[kk] = *(const bf16x8*)(p.Q + (tokb + s0 + myi) * D_ + h * 256 + kk * 16 + 8 * hhk);
      wait_vm0();
      __syncthreads();
      f32x16 o = zero16();
      if (ck > 0) {
        o = dot16_lds(r_l, et * 32 + l31k, hhk, qf, o);
#pragma unroll
        for (int i = 0; i < 16; ++i) o[i] *= qd;
      }
      for (int jt = 0; jt <= itl; ++jt) {
        f32x16 st = zero16();
        const int relb = launder(itl * 32 + l31k - jt * 32 - 4 * hhk);
        st = dot16_lds(k_l, jt * 32 + l31k, hhk, qf, st);
#pragma unroll
        for (int i = 0; i < 16; ++i) { int rel = relb - ((i & 3) + 8 * (i >> 2)); st[i] = rel >= 0 ? st[i] * ex2((float)rel * lg2) : 0.f; }
#pragma unroll
        for (int s = 0; s < 2; ++s) {
          u32x4 pb; pb.x = pack2(st[8 * s], st[8 * s + 1]); pb.y = pack2(st[8 * s + 2], st[8 * s + 3]); pb.z = pack2(st[8 * s + 4], st[8 * s + 5]); pb.w = pack2(st[8 * s + 6], st[8 * s + 7]);
          const bf16x8 bfrag = __builtin_bit_cast(bf16x8, pb);
          const char* rp = v_l + (et * 32 + l31k) * 264 + (jt * 32 + 16 * s + 4 * hhk) * 2;
          s16x4 lo = *(const s16x4*)rp, hi = *(const s16x4*)(rp + 16);
          bf16x8 afrag = __builtin_shufflevector(lo, hi, 0, 1, 2, 3, 4, 5, 6, 7);
          o = mfma(afrag, bfrag, o);
        }
      }
      {
        bf16_t* orow = p.Or + (tokb + s0 + myi) * 2048 + h * 512 + sl * 64 + et * 32;
#pragma unroll
        for (int q4 = 0; q4 < 4; ++q4) {
          u32x2 pk; pk.x = pack2(o[4 * q4], o[4 * q4 + 1]); pk.y = pack2(o[4 * q4 + 2], o[4 * q4 + 3]);
          *(u32x2*)(orow + 8 * q4 + 4 * hhk) = pk;
        }
      }
      asm volatile("" ::: "memory");
      if (ck < 15) {
        const bf16_t* kdr = p.Vt + ((size_t)bh * 256 + w * 32 + l31k) * S_ + s0;
        bf16x8 ka[8];
#pragma unroll
        for (int kk = 0; kk < 8; ++kk) ka[kk] = *(const bf16x8*)(kdr + kk * 16 + 8 * hhk);
#pragma unroll
        for (int nt = 0; nt < 2; ++nt) {
#pragma unroll
          for (int i = 0; i < 16; ++i) R[nt][i] *= cd;
#pragma unroll
          for (int kk = 0; kk < 8; ++kk) {
            const char* rp = v_l + (nt * 32 + l31k) * 264 + (kk * 16 + 8 * hhk) * 2;
            s16x4 lo = *(const s16x4*)rp, hi = *(const s16x4*)(rp + 8);
            bf16x8 bfrag = __builtin_shufflevector(lo, hi, 0, 1, 2, 3, 4, 5, 6, 7);
            R[nt] = mfma(ka[kk], bfrag, R[nt]);
          }
        }
        __syncthreads();
#pragma unroll
        for (int nt = 0; nt < 2; ++nt) {
          const int e = nt * 32 + l31k;
#pragma unroll
          for (int q4 = 0; q4 < 4; ++q4) {
            int d = w * 32 + 8 * q4 + 4 * hhk;
            u32x2 pk; pk.x = pack2(R[nt][4 * q4], R[nt][4 * q4 + 1]); pk.y = pack2(R[nt][4 * q4 + 2], R[nt][4 * q4 + 3]);
            *(u32x2*)(r_l + e * 512 + (((d >> 3) ^ (e & 15)) << 4) + (d & 7) * 2) = pk;
          }
        }
      }
    }
  }
}

DI void phase_ret_norm(const Params& p) {
  const int tid = launder(threadIdx.x), lane = tid & 63, w = tid >> 6;
  const int nxw = ((int)gridDim.x >> 3) * 8;
  for (int lr = ((int)blockIdx.x >> 3) * 8 + w; lr < 8192 && (int)blockIdx.x < ((int)gridDim.x & ~7); lr += nxw) {
    const int r = (blockIdx.x & 7) * 8192 + lr;
    bf16_t* op = p.Or + (size_t)r * 512 + lane * 8;
    const bf16_t* gp = p.G + (size_t)r * 512 + lane * 8;
    u32x4 ov = *(const u32x4*)op, gv = *(const u32x4*)gp;
    float o[8], g[8];
#pragma unroll
    for (int i = 0; i < 4; ++i) { o[2 * i] = __uint_as_float(ov[i] << 16); o[2 * i + 1] = __uint_as_float(ov[i] & 0xffff0000u); g[2 * i] = __uint_as_float(gv[i] << 16); g[2 * i + 1] = __uint_as_float(gv[i] & 0xffff0000u); }
    float s = 0.f;
#pragma unroll
    for (int i = 0; i < 8; ++i) s += o[i];
#pragma unroll
    for (int of = 32; of > 0; of >>= 1) s += __shfl_xor(s, of);
    const float mu = s * (1.f / 512.f);
    float q = 0.f;
#pragma unroll
    for (int i = 0; i < 8; ++i) { float d = o[i] - mu; q += d * d; }
#pragma unroll
    for (int of = 32; of > 0; of >>= 1) q += __shfl_xor(q, of);
    const float rs = rsqrtf(q * (1.f / 512.f) + LN_EPS);
    u32x4 res;
#pragma unroll
    for (int i = 0; i < 4; ++i) {
      float a = (o[2 * i] - mu) * rs * (g[2 * i] / (1.f + __expf(-g[2 * i])));
      float b2 = (o[2 * i + 1] - mu) * rs * (g[2 * i + 1] / (1.f + __expf(-g[2 * i + 1])));
      res[i] = pack2(a, b2);
    }
    *(u32x4*)op = res;
  }
}

DI void phase_pool(const Params& p) {
  const size_t per = (size_t)S_ * 256;
  const size_t lsz = (size_t)((int)gridDim.x >> 3) * NT;
  for (size_t li = (size_t)((int)blockIdx.x >> 3) * NT + launder(threadIdx.x); li < per && (int)blockIdx.x < ((int)gridDim.x & ~7); li += lsz) {
    const size_t i = (size_t)(blockIdx.x & 7) * per + li;
    const int t = (int)(i >> 8), c4 = (int)(i & 255);
    const int wdw = 2 << (c4 >> 6);
    const int s = t & (S_ - 1);
    const int n = (s + 1) < wdw ? (s + 1) : wdw;
    const f32x4 x0 = ((const f32x4*)p.X)[i];
    f32x4 sum = x0;
    for (int u = 1; u < n; ++u) sum += ((const f32x4*)p.X)[i - (size_t)u * 256];
    const float rn = 1.f / (float)n;
    f32x4 r = sum * rn - x0;
    u32x2 o; o.x = pack2(r[0], r[1]); o.y = pack2(r[2], r[3]);
    ((u32x2*)p.Oa)[i] = o;
  }
}


#define XB_TMO      128
#define XB_XCNT(j)  (256  + 64 * (j))
#define XB_XSUB(j)  (1280 + 64 * (j))
#define XB_XGEN(j)  (2304 + 64 * (j))
#define XB_TOP      3328
#define XB_TOPGEN   3392
#define XCD_BAR_WORDS 3456
#define XB_SPIN_CAP (1u << 20)
#define LAS __attribute__((address_space(3)))
DI unsigned xb_ld(unsigned* p)              { return __hip_atomic_load(p, __ATOMIC_RELAXED, __HIP_MEMORY_SCOPE_AGENT); }
DI unsigned xb_add(unsigned* p, unsigned v) { return __hip_atomic_fetch_add(p, v, __ATOMIC_RELAXED, __HIP_MEMORY_SCOPE_AGENT); }
DI unsigned xb_xcc_id() { return (unsigned)__builtin_amdgcn_s_getreg((3 << 11) | 20) & 0xFu; }
#define XB_SPIN(cond, bar) do { unsigned _sp = 0; while (cond) { __builtin_amdgcn_s_sleep(1); \
    if ((++_sp & 255u) == 0u) { if (xb_ld(&(bar)[XB_TMO])) break; if (_sp > XB_SPIN_CAP) { atomicAdd(&(bar)[XB_TMO], 1u); break; } } } } while (0)
struct XcdBarrier { unsigned* bar; unsigned x; volatile LAS unsigned* st; };
DI XcdBarrier xcd_barrier_post(unsigned* bar, volatile LAS unsigned* st) {
  XcdBarrier b; b.bar = bar; b.x = xb_xcc_id(); b.st = st;
  if (threadIdx.x == 0) (void)xb_add(&bar[XB_XCNT(b.x)], 1u);
  return b;
}
DI void xcd_barrier_complete(unsigned* bar, unsigned x, unsigned& nloc, unsigned& nx) {
  const unsigned G = gridDim.x * gridDim.y * gridDim.z;
  unsigned sum, cnt, mine, sp = 0u;
  for (;;) {
    sum = 0u; cnt = 0u; mine = 0u;
#pragma unroll
    for (unsigned j = 0; j < 16; ++j) { const unsigned c = xb_ld(&bar[XB_XCNT(j)]); sum += c; cnt += (c > 0u) ? 1u : 0u; mine = (j == x) ? c : mine; }
    if (sum == G) break;
    __builtin_amdgcn_s_sleep(1);
    if ((++sp & 255u) == 0u) { if (xb_ld(&bar[XB_TMO])) break; if (sp > XB_SPIN_CAP) { atomicAdd(&bar[XB_TMO], 1u); break; } }
  }
  nloc = mine > 0u ? mine : 1u; nx = cnt > 0u ? cnt : 1u;
}
DI void xcd_barrier(const XcdBarrier& b) {
  asm volatile("s_waitcnt vmcnt(0)" ::: "memory");
  __syncthreads();
  if (threadIdx.x == 0) {
    unsigned* bar = b.bar;
    __builtin_amdgcn_s_waitcnt(0);
    unsigned nloc = b.st[0], nx = b.st[1];
    if (nloc == 0u) { xcd_barrier_complete(bar, b.x, nloc, nx); b.st[0] = nloc; b.st[1] = nx; }
    const unsigned old = xb_add(&bar[XB_XSUB(b.x)], 1u);
    const unsigned gen = old / nloc;
    if (old + 1u == (gen + 1u) * nloc) {
      __builtin_amdgcn_fence(__ATOMIC_RELEASE, "agent");
      asm volatile("s_waitcnt vmcnt(0)" ::: "memory");
      const unsigned og = xb_add(&bar[XB_TOP], 1u);
      const unsigned tg = og / nx;
      if (og + 1u == (tg + 1u) * nx) xb_add(&bar[XB_TOPGEN], 1u);
      else XB_SPIN(xb_ld(&bar[XB_TOPGEN]) == tg, bar);
      __builtin_amdgcn_fence(__ATOMIC_ACQUIRE, "agent");
      xb_add(&bar[XB_XGEN(b.x)], 1u);
      asm volatile("s_waitcnt vmcnt(0)" ::: "memory");
    } else {
      XB_SPIN(xb_ld(&bar[XB_XGEN(b.x)]) == gen, bar);
      __builtin_amdgcn_fence(__ATOMIC_ACQUIRE, "agent");
      asm volatile("s_waitcnt vmcnt(0)" ::: "memory");
    }
  }
  __syncthreads();
}

__global__ void __launch_bounds__(NT) fwd_megakernel(Params p) {
  __shared__ __attribute__((aligned(16))) char lds[LDS_BYTES];
  cg::grid_group grid = cg::this_grid();
  __shared__ uint4 xb_words;
  if (threadIdx.x == 0) xb_words = make_uint4(0u, 0u, 0u, 0u);
  __syncthreads();
  const XcdBarrier xb = xcd_barrier_post(p.bar, (volatile LAS unsigned*)&xb_words);
  if (threadIdx.x == 0) { const unsigned r = xb_add(&p.xrank[xb.x * 64], 1u); __hip_atomic_store(&p.xrank[(8 + blockIdx.x) * 64], r * 8u + xb.x, __ATOMIC_RELAXED, __HIP_MEMORY_SCOPE_AGENT); }

  for (int rep_ = 0; rep_ < ((PROBE_DUP & 32) ? 2 : 1); ++rep_) { phase_prologue(p, lds); }
  if (p.njobs < 0) grid.sync();
  xcd_barrier(xb);
  int vb = blockIdx.x;
  {
    bool even = gridDim.x == 256;
#pragma unroll
    for (int q = 0; q < 8; ++q) even = even && (xb_ld(&p.xrank[q * 64]) == 32u);
    if (even) vb = (int)(xb_ld(&p.xrank[(8 + blockIdx.x) * 64]));
  }
  for (int st = -1; st < 16; ++st) {
    const int i = st >> 2, k = st & 3;
    const int mx = i % 3, j = i / 3;
    const int nsp = st < 0 ? 1 : (k == 0 || k == 3) ? 2 : k == 2 ? 3 : (mx == 0 ? 3 : mx == 1 ? 2 : 4);
    for (int sp = 0; sp < nsp; ++sp) {
      if (st < 0) {
        for (int t = blockIdx.x; t < 256; t += gridDim.x) {
          int layer = t >> 6, pm = t & 7, pn = (t >> 3) & 7;
          EpiXkv e{p.Kx + (size_t)layer * 2048 * D_, p.Vxt + (size_t)layer * 32 * 256 * 256};
          gemm_tile<4, 64>(p.memb, D_, p.wxkv[layer], D_, D_, pm * 256, pn * 256, lds, e);
        }
      } else if (k == 0 || k == 3) {
        const int f = k == 3 ? 1 : 0;
        if (sp == 0) {
          EpiSwiglu e1{p.H};
          for (int rep_ = 0; rep_ < ((PROBE_DUP & 1) ? 2 : 1); ++rep_) {
            gemm_phase256(p.Xb, D_, p.win[i * 2 + f], D_, 20, lds, e1, vb);
            for (int t = vb; t < 256; t += gridDim.x) {
              const int x = t & 7, L = t >> 3; const int pm = 8 * x + (L & 7), pnh = L >> 3;
              gemm_tile<4, 64, EpiSwiglu, 2>(p.Xb, D_, p.win[i * 2 + f], D_, D_, pm * 256, 5120 + pnh * 128, lds, e1);
            }
          }
        } else {
          const int lnidx = i * 4 + (f ? 3 : 0);
          EpiLNX e2{(st == 0) ? p.x : (const float*)p.X, (st == 15) ? p.out : p.X, p.Xb, nullptr, nullptr, p.ln_g + lnidx * D_, p.ln_b + lnidx * D_, 0.5f, p.xstat, p.xcnt, p.bar + XB_TMO, 4u * (unsigned)(lnidx + 1)};
          gemm_phaseLNX(p.H, F_, p.wout[i * 2 + f], lds, e2, vb);
        }
      } else if (k == 1) {
        const int lnidx = i * 4 + 1;
        const bool last = sp == nsp - 1;
        if (last) {
          const bf16_t* A = mx == 2 ? p.Or : p.Oa;
          const int K = mx == 2 ? 2048 : D_;
          const bf16_t* W = mx == 0 ? p.wdo[j] : mx == 1 ? p.wpool : p.wreto;
          EpiLNX e2{p.X, p.X, p.Xb, mx == 1 ? p.pool_b : nullptr, mx == 1 ? p.pool_scale : nullptr, p.ln_g + lnidx * D_, p.ln_b + lnidx * D_, 1.f, p.xstat, p.xcnt, p.bar + XB_TMO, 4u * (unsigned)(lnidx + 1)};
          gemm_phaseLNX(A, K, W, lds, e2, vb, mx == 1);
        } else if (mx == 0) {
          if (sp == 0) { EpiDAqkv e1{p.Q, p.Kb, p.Vt, p.cosD, p.sinD}; gemm_phase256(p.Xb, D_, p.wqkv[j], D_, 12, lds, e1, vb); }
          else for (int rep_ = 0; rep_ < ((PROBE_DUP & 4) ? 2 : 1); ++rep_) { phase_da_attn(p, j, lds); }
        } else if (mx == 1) {
          phase_pool(p);
        } else {
          if (sp == 0) { EpiRETqkvg e1{p.Q, p.Kb, p.Vt, p.Vrt, p.G, p.cosR, p.sinR}; gemm_phase256(p.Xb, D_, p.wret, D_, 24, lds, e1, vb); }
          else if (sp == 1) for (int rep_ = 0; rep_ < ((PROBE_DUP & 8) ? 2 : 1); ++rep_) { phase_ret(p, lds); }
          else phase_ret_norm(p);
        }
      } else {
        const int lnidx = i * 4 + 2;
        if (sp == 0) { EpiPlain e1{p.Q, 0.0625f}; gemm_phase256(p.Xb, D_, p.wxq[i], D_, 4, lds, e1, vb); }
        else if (sp == 1) for (int rep_ = 0; rep_ < ((PROBE_DUP & 16) ? 2 : 1); ++rep_) { phase_xa_attn(p, i, lds); }
        else { EpiLNX e2{p.X, p.X, p.Xb, nullptr, nullptr, p.ln_g + lnidx * D_, p.ln_b + lnidx * D_, 1.f, p.xstat, p.xcnt, p.bar + XB_TMO, 4u * (unsigned)(lnidx + 1)}; gemm_phaseLNX(p.Oa, D_, p.wxo[i], lds, e2, vb); }
      }
      if (!(st == 15 && sp == nsp - 1)) xcd_barrier(xb);
    }
  }
}

extern "C" void kernel_launch(void* const* d_in, const int* in_sizes, int n_in, void* d_out, int out_size, void* d_ws, size_t ws_size, hipStream_t stream) {
  (void)in_sizes; (void)n_in; (void)out_size;
  static Params p;
  static int grid_blocks = 0;
  static bool ok = true;
  if (!grid_blocks) {
    int dev = 0, cus = 0, per_cu = 0;
    hipGetDevice(&dev);
    hipDeviceGetAttribute(&cus, hipDeviceAttributeMultiprocessorCount, dev);
    hipOccupancyMaxActiveBlocksPerMultiprocessor(&per_cu, fwd_megakernel, NT, 0);
    if (per_cu < 1) per_cu = 1;
    grid_blocks = 256;
    if (cus < 256) { fprintf(stderr, "needs 256 CUs, device has %d\n", cus); ok = false; }
  }
  std::memset((void*)&p, 0, sizeof(p));
  const float* x = (const float*)d_in[0]; const float* mem = (const float*)d_in[1]; const int* pos = (const int*)d_in[2];
  const float* ffn_w_in = (const float*)d_in[3]; const float* ffn_w_out = (const float*)d_in[4];
  const float* ln_g = (const float*)d_in[5]; const float* ln_b = (const float*)d_in[6];
  const float* da_w_qkv = (const float*)d_in[7]; const float* da_w_o = (const float*)d_in[8];
  const float* da_lam_q = (const float*)d_in[9]; const float* da_lam_k = (const float*)d_in[10]; const float* da_subln_g = (const float*)d_in[11];
  const float* pool_w = (const float*)d_in[12]; const float* pool_b = (const float*)d_in[13]; const float* pool_scale = (const float*)d_in[14];
  const float* ret_w_qkvg = (const float*)d_in[15]; const float* ret_w_o = (const float*)d_in[16];
  const float* xa_wq = (const float*)d_in[17]; const float* xa_wkv = (const float*)d_in[18]; const float* xa_wo = (const float*)d_in[19];
  p.x = x; p.mem = mem; p.pos = pos; p.ln_g = ln_g; p.ln_b = ln_b; p.lam_q = da_lam_q; p.lam_k = da_lam_k; p.subln_g = da_subln_g; p.pool_b = pool_b; p.pool_scale = pool_scale;
  p.out = (float*)d_out;
  char* ws = (char*)d_ws; size_t off = 0;
  auto alloc = [&](size_t bytes) { char* r = ws + off; off += (bytes + 255) & ~(size_t)255; return r; };
  const size_t U = (size_t)T_ * 1024 * 2;
  p.bar = (unsigned*)alloc(XCD_BAR_WORDS * 4 + 64 * 256 + 264 * 256);
  p.xcnt = p.bar + XCD_BAR_WORDS;
  p.xrank = p.xcnt + 64 * 64;
  p.xstat = (u64_t*)alloc((size_t)64 * 256 * 4 * 8);
  p.X = (float*)alloc((size_t)T_ * D_ * 4); p.Xb = (bf16_t*)alloc(U); p.memb = (bf16_t*)alloc((size_t)2048 * D_ * 2);
  p.cosD = (float*)alloc((size_t)T_ * 32 * 4); p.sinD = (float*)alloc((size_t)T_ * 32 * 4);
  p.cosR = (float*)alloc((size_t)T_ * 128 * 4); p.sinR = (float*)alloc((size_t)T_ * 128 * 4);
  p.Kx = (bf16_t*)alloc((size_t)4 * 2048 * D_ * 2); p.Vxt = (bf16_t*)alloc((size_t)4 * 2048 * D_ * 2);
  char* big = alloc(10 * U);
  p.H = (bf16_t*)big; p.Q = (bf16_t*)big; p.Kb = (bf16_t*)(big + U); p.Vt = (bf16_t*)(big + 2 * U); p.Oa = (bf16_t*)(big + 3 * U);
  p.Vrt = (bf16_t*)(big + 4 * U); p.G = (bf16_t*)(big + 6 * U); p.Or = (bf16_t*)(big + 8 * U);
  int nj = 0; int tiles = 0;
  auto job = [&](const float* src, int K, int N, int lds_, int perm) {
    bf16_t* dst = (bf16_t*)alloc((size_t)K * N * 2);
    TJob& j = p.jobs[nj]; j.src = src; j.dst = dst; j.K = K; j.N = N; j.lds_ = lds_; j.ldd = K; j.perm = perm; j.pad = 0;
    p.tile_start[nj] = tiles; tiles += (K / 128) * (N / 128); ++nj; return (const bf16_t*)dst;
  };
  for (int i = 0; i < 8; ++i) {
    p.win[i] = job(ffn_w_in + (size_t)i * D_ * 2 * F_, D_, 2 * F_, 2 * F_, 1);
    p.wout[i] = job(ffn_w_out + (size_t)i * F_ * D_, F_, D_, D_, 0);
  }
  for (int j = 0; j < 2; ++j) {
    p.wqkv[j] = job(da_w_qkv + (size_t)j * D_ * 3072, D_, 3072, 3072, 0);
    p.wdo[j] = job(da_w_o + (size_t)j * D_ * D_, D_, D_, D_, 0);
  }
  p.wret = job(ret_w_qkvg, D_, 6144, 6144, 3);
  p.wreto = job(ret_w_o, 2048, D_, D_, 0);
  for (int i = 0; i < 4; ++i) {
    p.wxq[i] = job(xa_wq + (size_t)i * D_ * D_, D_, D_, D_, 0);
    p.wxkv[i] = job(xa_wkv + (size_t)i * D_ * 2048, D_, 2048, 2048, 0);
    p.wxo[i] = job(xa_wo + (size_t)i * D_ * D_, D_, D_, D_, 0);
  }
  p.wpool = job(pool_w, D_, D_, 256, 4);
  p.njobs = nj; p.tile_start[nj] = tiles;
  p.lam_init[0] = (float)(0.8 - 0.6 * exp(-0.3 * 0.0));
  p.lam_init[1] = (float)(0.8 - 0.6 * exp(-0.3 * 3.0));
  if (!ok) return;
  if (off > ws_size || nj != NJOBS) { if (ok) fprintf(stderr, "workspace too small or job count mismatch: need %zu have %zu, jobs %d\n", off, ws_size, nj); ok = false; return; }
  hipMemsetAsync(p.bar, 0, XCD_BAR_WORDS * 4 + 64 * 256 + 264 * 256, stream);
  void* args[] = {&p};
  hipError_t e = hipLaunchCooperativeKernel((void*)fwd_megakernel, dim3(grid_blocks), dim3(NT), args, 0, stream);
  if (e != hipSuccess) fprintf(stderr, "cooperative launch failed: %s (grid %d)\n", hipGetErrorString(e), grid_blocks);
}
```
